# Optimizing an MI355X kernel written in HIP

```python
import math
import jax, jax.numpy as jnp
from jax import lax
import numpy as np

D_MODEL = 1024
BATCH = 2
SEQ = 8192
DEPTH = 4

GRID_W = 64
HEAD_DIM = 64
BLOCK = 128
NA_HEADS = 8
NA_WIN_ROWS = 8
NA_WIN_COLS = 16
DIFF_HEADS = 4
SWA_Q_HEADS = 16
SWA_KV_HEADS = 4
SWA_WINDOW = 128
PEER_HEADS = 8
PEER_N_KEYS = 128
PEER_N_EXPERTS = PEER_N_KEYS * PEER_N_KEYS
PEER_KEY_DIM = 256
PEER_TOPK = 16

ROPE_THETA = 10000.0
LN_EPS = 1e-5
NEG = -1e30
DEEPNORM_ALPHA = (2 * DEPTH) ** 0.25
DEEPNORM_BETA = (8 * DEPTH) ** -0.25
N_EVEN = (DEPTH + 1) // 2
N_ODD = DEPTH // 2

A_WIDTH = NA_HEADS * HEAD_DIM
B_QK_WIDTH = DIFF_HEADS * 2 * HEAD_DIM
B_V_WIDTH = DIFF_HEADS * 2 * HEAD_DIM
EVEN_IN = 3 * A_WIDTH + 2 * B_QK_WIDTH + B_V_WIDTH
C_Q = SWA_Q_HEADS * HEAD_DIM
C_KV = SWA_KV_HEADS * HEAD_DIM
ODD_IN = C_Q + 2 * C_KV

kernel_name = "hybrid_natten_diff_swa_peer_encoder"


def layer_norm(x, g, b):
    xf = x.astype(jnp.float32)
    mu = jnp.mean(xf, -1, keepdims=True)
    var = jnp.mean(jnp.square(xf - mu), -1, keepdims=True)
    return ((xf - mu) * lax.rsqrt(var + LN_EPS) * g.astype(jnp.float32) + b.astype(jnp.float32)).astype(x.dtype)


def rope_tables(seq):
    inv = 1.0 / (ROPE_THETA ** (jnp.arange(0, HEAD_DIM, 2, dtype=jnp.float32) / HEAD_DIM))
    ang = jnp.arange(seq, dtype=jnp.float32)[:, None] * inv[None, :]
    return jnp.cos(ang), jnp.sin(ang)


def apply_rope(t, cos, sin):
    shp = (1, t.shape[1]) + (1,) * (t.ndim - 3) + (HEAD_DIM // 2,)
    cs, sn = cos.reshape(shp), sin.reshape(shp)
    t1, t2 = jnp.split(t.astype(jnp.float32), 2, -1)
    return jnp.concatenate([t1 * cs - t2 * sn, t1 * sn + t2 * cs], -1).astype(t.dtype)


def neighbourhood_attention(q, k, v, rpb):
    B, S = q.shape[:2]
    rows = S // GRID_W
    wr = min(NA_WIN_ROWS, rows)
    to_grid = lambda t: t.reshape(B, rows, GRID_W, NA_HEADS, HEAD_DIM)
    qg, kg, vg = to_grid(q), to_grid(k), to_grid(v)
    r = jnp.arange(rows)
    row_start = jnp.clip(r - wr // 2, 0, rows - wr)
    key_rows = row_start[:, None] + jnp.arange(wr)[None, :]
    kb = kg[:, key_rows]
    vb = vg[:, key_rows]
    cidx = jnp.arange(GRID_W)
    col_start = jnp.clip(cidx - NA_WIN_COLS // 2, 0, GRID_W - NA_WIN_COLS)
    col_ok = (cidx[None, :] >= col_start[:, None]) & (cidx[None, :] < col_start[:, None] + NA_WIN_COLS)
    dr = key_rows - r[:, None]
    dc = cidx[None, :] - cidx[:, None]
    bias = rpb[:, dr + NA_WIN_ROWS - 1]
    bias = jnp.take(bias, jnp.clip(dc + NA_WIN_COLS - 1, 0, 2 * NA_WIN_COLS - 2), axis=-1)
    bias = bias.transpose(0, 1, 3, 2, 4).astype(jnp.float32)
    s = jnp.einsum('brqhd,brwkhd->bhrqwk', qg, kb).astype(jnp.float32) * (HEAD_DIM ** -0.5)
    s = jnp.where(col_ok[None, None, None, :, None, :], s + bias[None], NEG)
    p = jax.nn.softmax(s.reshape(s.shape[:4] + (wr * GRID_W,)), -1).reshape(s.shape).astype(v.dtype)
    o = jnp.einsum('bhrqwk,brwkhd->brqhd', p, vb)
    return o.reshape(B, S, A_WIDTH)


def diff_attention(q, k, v, lam, sub_g, lambda_init):
    B, S = q.shape[:2]
    nb = S // BLOCK
    qb = q.reshape(B, nb, BLOCK, DIFF_HEADS, 2, HEAD_DIM).transpose(1, 0, 2, 3, 4, 5)

    def one_block(qblk):
        s = jnp.einsum('bqhmd,bkhmd->bhmqk', qblk, k).astype(jnp.float32) * (HEAD_DIM ** -0.5)
        p = jax.nn.softmax(s, -1)
        w = (p[:, :, 0] - lam * p[:, :, 1]).astype(v.dtype)
        return jnp.einsum('bhqk,bkhe->bqhe', w, v)

    o = lax.map(one_block, qb)
    o = o.transpose(1, 0, 2, 3, 4).reshape(B, S, DIFF_HEADS, 2 * HEAD_DIM).astype(jnp.float32)
    o = o * lax.rsqrt(jnp.mean(o * o, -1, keepdims=True) + LN_EPS) * sub_g.astype(jnp.float32)
    return (o * (1.0 - lambda_init)).astype(q.dtype).reshape(B, S, B_V_WIDTH)


def sliding_window_gqa(q, k, v, sink):
    B, S = q.shape[:2]
    nb = S // BLOCK
    G = SWA_Q_HEADS // SWA_KV_HEADS
    qb = q.reshape(B, nb, BLOCK, SWA_KV_HEADS, G, HEAD_DIM)
    pad = lambda t: jnp.pad(t, ((0, 0), (BLOCK, BLOCK), (0, 0), (0, 0))).reshape(B, nb + 2, BLOCK, SWA_KV_HEADS, HEAD_DIM)
    band = lambda t: jnp.concatenate([t[:, i:i + nb] for i in range(3)], axis=2)
    kb, vb = band(pad(k)), band(pad(v))
    s = jnp.einsum('bnqhgd,bnkhd->bnhgqk', qb, kb).astype(jnp.float32) * (HEAD_DIM ** -0.5)
    blk = jnp.arange(nb)[:, None, None]
    qpos = blk * BLOCK + jnp.arange(BLOCK)[None, :, None]
    kpos = (blk - 1) * BLOCK + jnp.arange(3 * BLOCK)[None, None, :]
    ok = (jnp.abs(qpos - kpos) <= SWA_WINDOW) & (kpos >= 0) & (kpos < S)
    s = jnp.where(ok[None, :, None, None], s, NEG)
    sink_l = sink.astype(jnp.float32).reshape(1, 1, SWA_KV_HEADS, G, 1, 1)
    m = jnp.maximum(jnp.max(s, -1, keepdims=True), sink_l)
    e = jnp.exp(s - m)
    p = e / (jnp.sum(e, -1, keepdims=True) + jnp.exp(sink_l - m))
    o = jnp.einsum('bnhgqk,bnkhd->bnqhgd', p.astype(v.dtype), vb)
    return o.reshape(B, S, C_Q)


def peer(h, w_query, sub_keys, expert_u, expert_v):
    B, S, D = h.shape
    nb = S // BLOCK
    half = PEER_KEY_DIM // 2
    hb = h.reshape(B, nb, BLOCK, D).transpose(1, 0, 2, 3)

    def one_block(xb):
        q = jnp.einsum('btd,de->bte', xb, w_query).reshape(B, BLOCK, PEER_HEADS, 2, half)
        s = jnp.einsum('bthpe,hpne->bthpn', q, sub_keys).astype(jnp.float32)
        sv, si = lax.top_k(s, PEER_TOPK)
        cand = sv[..., 0, :, None] + sv[..., 1, None, :]
        cidx = si[..., 0, :, None] * PEER_N_KEYS + si[..., 1, None, :]
        fv, fpos = lax.top_k(cand.reshape(B, BLOCK, PEER_HEADS, PEER_TOPK * PEER_TOPK), PEER_TOPK)
        eidx = jnp.take_along_axis(cidx.reshape(B, BLOCK, PEER_HEADS, PEER_TOPK * PEER_TOPK), fpos, -1)
        g = jax.nn.softmax(fv, -1)
        u = expert_u[eidx]
        act = jax.nn.gelu(jnp.einsum('btd,bthkd->bthk', xb, u).astype(jnp.float32), approximate=False)
        w = (g * act).astype(xb.dtype)
        return jnp.einsum('bthk,bthkd->btd', w, expert_v[eidx])

    o = lax.map(one_block, hb)
    return o.transpose(1, 0, 2, 3).reshape(B, S, D)


def setup_inputs(seed: int = 0) -> dict:
    key = jax.random.key(seed)
    ks = jax.random.split(key, 24)
    D = D_MODEL
    nrm = lambda k, shape, s: jax.random.normal(k, shape, jnp.float32) * s
    x = nrm(ks[0], (BATCH, SEQ, D), 1.0)
    c = nrm(ks[1], (BATCH, D), 1.0)
    w_ada = nrm(ks[2], (DEPTH, 2, D, 3 * D), 0.1 * D ** -0.5)
    b_ada = jnp.concatenate([nrm(ks[3], (DEPTH, 2, 2 * D), 0.02), 1.0 + nrm(ks[4], (DEPTH, 2, D), 0.02)], -1)
    ln_g = 1.0 + nrm(ks[5], (DEPTH, 2, D), 0.02)
    ln_b = nrm(ks[6], (DEPTH, 2, D), 0.02)
    even_scale = jnp.asarray(np.concatenate([np.ones(2 * A_WIDTH), np.full(A_WIDTH, DEEPNORM_BETA),
                                             np.ones(2 * B_QK_WIDTH), np.full(B_V_WIDTH, DEEPNORM_BETA)]), jnp.float32)
    w_in_even = nrm(ks[7], (N_EVEN, D, EVEN_IN), D ** -0.5) * even_scale
    rpb = nrm(ks[8], (N_EVEN, NA_HEADS, 2 * NA_WIN_ROWS - 1, 2 * NA_WIN_COLS - 1), 0.02)
    lam_q1 = nrm(ks[9], (N_EVEN, HEAD_DIM), 0.1)
    lam_k1 = nrm(ks[10], (N_EVEN, HEAD_DIM), 0.1)
    lam_q2 = nrm(ks[11], (N_EVEN, HEAD_DIM), 0.1)
    lam_k2 = nrm(ks[12], (N_EVEN, HEAD_DIM), 0.1)
    diff_sub_g = 1.0 + nrm(ks[13], (N_EVEN, 2 * HEAD_DIM), 0.02)
    w_out_even = nrm(ks[14], (N_EVEN, D, D), DEEPNORM_BETA * D ** -0.5)
    odd_scale = jnp.asarray(np.concatenate([np.ones(C_Q + C_KV), np.full(C_KV, DEEPNORM_BETA)]), jnp.float32)
    w_in_odd = nrm(ks[15], (N_ODD, D, ODD_IN), D ** -0.5) * odd_scale
    sink = nrm(ks[16], (N_ODD, SWA_Q_HEADS), 0.5)
    w_out_odd = nrm(ks[17], (N_ODD, D, D), DEEPNORM_BETA * D ** -0.5)
    peer_w_query = nrm(ks[18], (DEPTH, D, PEER_HEADS * PEER_KEY_DIM), D ** -0.5)
    peer_sub_keys = nrm(ks[19], (DEPTH, PEER_HEADS, 2, PEER_N_KEYS, PEER_KEY_DIM // 2), (PEER_KEY_DIM // 2) ** -0.5)
    peer_u = nrm(ks[20], (DEPTH, PEER_N_EXPERTS, D), D ** -0.5)
    peer_v = nrm(ks[21], (DEPTH, PEER_N_EXPERTS, D), DEEPNORM_BETA * PEER_HEADS ** -0.5)
    return {"x": x, "c": c, "w_ada": w_ada, "b_ada": b_ada, "ln_g": ln_g, "ln_b": ln_b,
            "w_in_even": w_in_even, "rpb": rpb, "lam_q1": lam_q1, "lam_k1": lam_k1,
            "lam_q2": lam_q2, "lam_k2": lam_k2, "diff_sub_g": diff_sub_g, "w_out_even": w_out_even,
            "w_in_odd": w_in_odd, "sink": sink, "w_out_odd": w_out_odd,
            "peer_w_query": peer_w_query, "peer_sub_keys": peer_sub_keys, "peer_u": peer_u, "peer_v": peer_v}


def reference(x, c, w_ada, b_ada, ln_g, ln_b, w_in_even, rpb, lam_q1, lam_k1, lam_q2, lam_k2, diff_sub_g,
              w_out_even, w_in_odd, sink, w_out_odd, peer_w_query, peer_sub_keys, peer_u, peer_v):
    B, S, D = x.shape
    cos, sin = rope_tables(S)
    cond = jax.nn.silu(c.astype(jnp.float32)).astype(x.dtype)
    mods = jnp.einsum('bd,lsde->lsbe', cond, w_ada) + b_ada[:, :, None, :]
    even_splits = [A_WIDTH, 2 * A_WIDTH, 3 * A_WIDTH, 3 * A_WIDTH + B_QK_WIDTH, 3 * A_WIDTH + 2 * B_QK_WIDTH]
    odd_splits = [C_Q, C_Q + C_KV]
    for layer in range(DEPTH):
        shift, scale, gate = jnp.split(mods[layer, 0], 3, -1)
        h = x * (1.0 + scale[:, None]) + shift[:, None]
        if layer % 2 == 0:
            i = layer // 2
            proj = jnp.einsum('bsd,de->bse', h, w_in_even[i])
            qa, ka, va, qb, kb, vb = jnp.split(proj, even_splits, -1)
            hd4 = lambda t: t.reshape(B, S, NA_HEADS, HEAD_DIM)
            o_a = neighbourhood_attention(hd4(qa), hd4(ka), hd4(va), rpb[i])
            qb = apply_rope(qb.reshape(B, S, DIFF_HEADS, 2, HEAD_DIM), cos, sin)
            kb = apply_rope(kb.reshape(B, S, DIFF_HEADS, 2, HEAD_DIM), cos, sin)
            lambda_init = 0.8 - 0.6 * math.exp(-0.3 * layer)
            lam = (jnp.exp(jnp.sum(lam_q1[i].astype(jnp.float32) * lam_k1[i].astype(jnp.float32)))
                   - jnp.exp(jnp.sum(lam_q2[i].astype(jnp.float32) * lam_k2[i].astype(jnp.float32))) + lambda_init)
            o_b = diff_attention(qb, kb, vb.reshape(B, S, DIFF_HEADS, 2 * HEAD_DIM), lam, diff_sub_g[i], lambda_init)
            y = jnp.einsum('bse,ed->bsd', jnp.concatenate([o_a, o_b], -1), w_out_even[i])
        else:
            j = layer // 2
            proj = jnp.einsum('bsd,de->bse', h, w_in_odd[j])
            qc, kc, vc = jnp.split(proj, odd_splits, -1)
            qc = apply_rope(qc.reshape(B, S, SWA_Q_HEADS, HEAD_DIM), cos, sin)
            kc = apply_rope(kc.reshape(B, S, SWA_KV_HEADS, HEAD_DIM), cos, sin)
            o_c = sliding_window_gqa(qc, kc, vc.reshape(B, S, SWA_KV_HEADS, HEAD_DIM), sink[j])
            y = jnp.einsum('bse,ed->bsd', o_c, w_out_odd[j])
        x = layer_norm(DEEPNORM_ALPHA * x + gate[:, None] * y, ln_g[layer, 0], ln_b[layer, 0])
        shift2, scale2, gate2 = jnp.split(mods[layer, 1], 3, -1)
        h2 = x * (1.0 + scale2[:, None]) + shift2[:, None]
        y2 = peer(h2, peer_w_query[layer], peer_sub_keys[layer], peer_u[layer], peer_v[layer])
        x = layer_norm(DEEPNORM_ALPHA * x + gate2[:, None] * y2, ln_g[layer, 1], ln_b[layer, 1])
    return x
```

```cpp
#include <hip/hip_runtime.h>
#include <hip/hip_cooperative_groups.h>
#include <cstdio>
namespace cg = cooperative_groups;

#ifndef DUP_MASK
#define DUP_MASK 0
#endif
#ifndef FUSED_TOPK
#define FUSED_TOPK 1
#ifndef TOPK_SEPARATE
#define TOPK_SEPARATE 0
#endif
#endif
#ifndef NAIVE_ATTN
#define NAIVE_ATTN 0
#endif
#ifndef ONE_LAUNCH
#define ONE_LAUNCH 1
#endif

#define DI __device__ __forceinline__
typedef unsigned short bf16_t;
using bf16x8 = __attribute__((ext_vector_type(8))) short;
using f32x16 = __attribute__((ext_vector_type(16))) float;

constexpr int NB = 2, S = 8192, D = 1024, M = NB * S, DEPTH = 4;
constexpr int EVEN_IN = 3072, ODD_IN = 1536, NEXP = 16384;
constexpr float ALPHA = 1.681792830507429f;
constexpr float LN_EPS = 1e-5f;
constexpr float U_SCALE = 64.0f, V_SCALE = 8.0f;
using u32x4 = __attribute__((ext_vector_type(4))) unsigned;
constexpr int NTHR = 256;
constexpr int LDS_BYTES = 74752;
constexpr int NPHASE = 2 + 8 * DEPTH;

constexpr int XCD_BAR_WORDS_C = 3456;
constexpr size_t al256(size_t x) { return (x + 255) & ~(size_t)255; }
constexpr size_t OFF_mods = 0;
constexpr size_t OFF_ropec = OFF_mods + al256((size_t)DEPTH * 2 * 2 * 3072 * 4);
constexpr size_t OFF_ropes = OFF_ropec + al256((size_t)S * 32 * 4);
constexpr size_t OFF_lam = OFF_ropes + al256((size_t)S * 32 * 4);
constexpr size_t OFF_subkT = OFF_lam + al256(256);
constexpr size_t OFF_w_in_even_t = OFF_subkT + al256((size_t)DEPTH * 16 * 128 * 128 * 4);
constexpr size_t OFF_w_out_even_t = OFF_w_in_even_t + al256((size_t)2 * D * EVEN_IN * 2);
constexpr size_t OFF_w_in_odd_t = OFF_w_out_even_t + al256((size_t)2 * D * D * 2);
constexpr size_t OFF_w_out_odd_t = OFF_w_in_odd_t + al256((size_t)2 * D * ODD_IN * 2);
constexpr size_t OFF_wq_t = OFF_w_out_odd_t + al256((size_t)2 * D * D * 2);
constexpr size_t OFF_u_bf = OFF_wq_t + al256((size_t)DEPTH * D * 2048 * 2);
constexpr size_t OFF_v_bf = OFF_u_bf + al256((size_t)DEPTH * NEXP * D * 2);
constexpr size_t OFF_xcur = OFF_v_bf + al256((size_t)DEPTH * NEXP * D * 2);
constexpr size_t OFF_zbuf = OFF_xcur + al256(256);
constexpr size_t OFF_qpeer = OFF_zbuf + al256((size_t)M * D * 4);
constexpr size_t OFF_sv = OFF_qpeer + al256(256);
constexpr size_t OFF_dtmp = OFF_sv + al256((size_t)M * 256 * 4);
constexpr size_t OFF_si = OFF_dtmp + al256(256);
constexpr size_t OFF_hbuf = OFF_si + al256((size_t)M * 256 * 4);
constexpr size_t OFF_proj = OFF_hbuf + al256((size_t)M * D * 2);
constexpr size_t OFF_obuf = OFF_proj + al256((size_t)M * EVEN_IN * 2);
constexpr size_t OFF_vT = OFF_obuf + al256((size_t)M * D * 2);
constexpr size_t OFF_x2buf = OFF_vT + al256((size_t)M * D * 2);
constexpr size_t OFF_bar = OFF_x2buf + al256((size_t)M * D * 4);
constexpr size_t WS_TOTAL = OFF_bar + al256((size_t)XCD_BAR_WORDS_C * 4);

struct Params {
  const float *x, *c, *w_ada, *b_ada, *ln_g, *ln_b, *w_in_even, *rpb, *lq1, *lk1, *lq2, *lk2, *sub_g, *w_out_even,
      *w_in_odd, *sink, *w_out_odd, *wq, *subk, *pu, *pv;
  float* out;
  char* ws;
  int ph_lo, ph_hi;
  DI float* mods() const { return (float*)(ws + OFF_mods); }
  DI float* ropec() const { return (float*)(ws + OFF_ropec); }
  DI float* ropes() const { return (float*)(ws + OFF_ropes); }
  DI float* lam() const { return (float*)(ws + OFF_lam); }
  DI float* subkT() const { return (float*)(ws + OFF_subkT); }
  DI bf16_t* w_in_even_t() const { return (bf16_t*)(ws + OFF_w_in_even_t); }
  DI bf16_t* w_out_even_t() const { return (bf16_t*)(ws + OFF_w_out_even_t); }
  DI bf16_t* w_in_odd_t() const { return (bf16_t*)(ws + OFF_w_in_odd_t); }
  DI bf16_t* w_out_odd_t() const { return (bf16_t*)(ws + OFF_w_out_odd_t); }
  DI bf16_t* wq_t() const { return (bf16_t*)(ws + OFF_wq_t); }
  DI bf16_t* u_bf() const { return (bf16_t*)(ws + OFF_u_bf); }
  DI bf16_t* v_bf() const { return (bf16_t*)(ws + OFF_v_bf); }
  DI float* xcur() const { return (float*)(ws + OFF_xcur); }
  DI float* zbuf() const { return (float*)(ws + OFF_zbuf); }
  DI float* qpeer() const { return (float*)(ws + OFF_qpeer); }
  DI float* sv() const { return (float*)(ws + OFF_sv); }
  DI float* dtmp() const { return (float*)(ws + OFF_dtmp); }
  DI int* si() const { return (int*)(ws + OFF_si); }
  DI bf16_t* hbuf() const { return (bf16_t*)(ws + OFF_hbuf); }
  DI bf16_t* proj() const { return (bf16_t*)(ws + OFF_proj); }
  DI bf16_t* obuf() const { return (bf16_t*)(ws + OFF_obuf); }
  DI bf16_t* vT() const { return (bf16_t*)(ws + OFF_vT); }
  DI float* x2buf() const { return (float*)(ws + OFF_x2buf); }
};

DI float bf2f(bf16_t v) { return __uint_as_float(((unsigned)v) << 16); }
DI bf16_t f2bf(float f) { unsigned u = __float_as_uint(f); u += 0x7fffu + ((u >> 16) & 1u); return (bf16_t)(u >> 16); }
DI float bflo(unsigned u) { return __uint_as_float(u << 16); }
DI float bfhi(unsigned u) { return __uint_as_float(u & 0xffff0000u); }
DI unsigned pack2(float a, float b) { return (unsigned)f2bf(a) | ((unsigned)f2bf(b) << 16); }
typedef __bf16 hwbf16x2 __attribute__((ext_vector_type(2)));
typedef float hwf32x2 __attribute__((ext_vector_type(2)));
DI unsigned pack2_hw(float a, float b) {
  const hwf32x2 v = {a, b};
  return __builtin_bit_cast(unsigned, __builtin_convertvector(v, hwbf16x2));
}
DI unsigned ordkey(float f) { unsigned u = __float_as_uint(f); return u ^ ((unsigned)((int)u >> 31) | 0x80000000u); }
DI float unordkey(unsigned k) { unsigned u = (k & 0x80000000u) ? (k ^ 0x80000000u) : ~k; return __uint_as_float(u); }
template <int CTRL> DI float dpp_f(float v) { return __int_as_float(__builtin_amdgcn_mov_dpp(__float_as_int(v), CTRL, 0xf, 0xf, true)); }
DI float wave_sum(float v) {
  v += dpp_f<0xB1>(v);
  v += dpp_f<0x4E>(v);
  v += dpp_f<0x141>(v);
  v += dpp_f<0x140>(v);
  const float a = __int_as_float(__builtin_amdgcn_readlane(__float_as_int(v), 0)), b = __int_as_float(__builtin_amdgcn_readlane(__float_as_int(v), 16));
  const float c = __int_as_float(__builtin_amdgcn_readlane(__float_as_int(v), 32)), d = __int_as_float(__builtin_amdgcn_readlane(__float_as_int(v), 48));
  return (a + b) + (c + d);
}
DI float xhalf_max(float x) {
  auto r = __builtin_amdgcn_permlane32_swap(__float_as_uint(x), __float_as_uint(x), false, false);
  return fmaxf(__uint_as_float(r[0]), __uint_as_float(r[1]));
}
DI float xhalf_sum(float x) {
  auto r = __builtin_amdgcn_permlane32_swap(__float_as_uint(x), __float_as_uint(x), false, false);
  return __uint_as_float(r[0]) + __uint_as_float(r[1]);
}

template <typename TO> DI TO cvt_out(float v);
template <> DI float cvt_out<float>(float v) { return v; }
template <> DI bf16_t cvt_out<bf16_t>(float v) { return f2bf(v); }

template <typename TO>
DI void transpose_convert(const float* __restrict__ src, TO* __restrict__ dst, int K, int N, char* smem, int tid_, int bid_) {
  float (*tile)[65] = (float (*)[65])smem;
  const int tid = tid_;
  const int tn_cnt = N / 64, ntile = (K / 64) * tn_cnt;
  for (int t = bid_; t < ntile; t += gridDim.x) {
    const int tk = t / tn_cnt, tn = t % tn_cnt;
#pragma unroll 4
    for (int i = 0; i < 16; ++i) {
      int idx = tid + i * 256, kk = idx >> 6, nn = idx & 63;
      tile[kk][nn] = src[(size_t)(tk * 64 + kk) * N + tn * 64 + nn];
    }
    __syncthreads();
#pragma unroll 4
    for (int i = 0; i < 16; ++i) {
      int idx = tid + i * 256, nn = idx >> 6, kk = idx & 63;
      dst[(size_t)(tn * 64 + nn) * K + tk * 64 + kk] = cvt_out<TO>(tile[kk][nn]);
    }
    __syncthreads();
  }
}

DI void phase_prep(const Params& p, char* smem, int tid_, int bid_) {
  const int tid = tid_;
  {
    float* red = (float*)smem;
    for (int task = bid_; task < 8 * 48; task += gridDim.x) {
      const int ls = task / 48, cb = task % 48;
      const int col = tid & 63, kg = tid >> 6;
      float a0 = 0.f, a1 = 0.f;
      const float* w = p.w_ada + ((size_t)ls * D + kg * 256) * 3072 + cb * 64 + col;
      for (int k = 0; k < 256; ++k) {
        float c0 = p.c[kg * 256 + k], c1 = p.c[D + kg * 256 + k];
        c0 = c0 / (1.f + __expf(-c0));
        c1 = c1 / (1.f + __expf(-c1));
        float wv = w[(size_t)k * 3072];
        a0 += c0 * wv;
        a1 += c1 * wv;
      }
      red[(kg * 64 + col) * 2 + 0] = a0;
      red[(kg * 64 + col) * 2 + 1] = a1;
      __syncthreads();
      if (tid < 128) {
        const int cc = tid & 63, b = tid >> 6;
        float s = red[(0 * 64 + cc) * 2 + b] + red[(1 * 64 + cc) * 2 + b] + red[(2 * 64 + cc) * 2 + b] + red[(3 * 64 + cc) * 2 + b];
        const int e = cb * 64 + cc;
        p.mods()[((size_t)ls * 2 + b) * 3072 + e] = s + p.b_ada[(size_t)ls * 3072 + e];
      }
      __syncthreads();
    }
  }
  for (int idx = bid_ * NTHR + tid; idx < S * 32; idx += gridDim.x * NTHR) {
    const int pos = idx >> 5, j = idx & 31;
    const float inv = 1.0f / powf(10000.0f, (float)(2 * j) / 64.0f);
    const float ang = (float)pos * inv;
    p.ropec()[idx] = cosf(ang);
    p.ropes()[idx] = sinf(ang);
  }
  if (bid_ == 0 && tid < 2) {
    const int i = tid;
    float s1 = 0.f, s2 = 0.f;
    for (int d = 0; d < 64; ++d) {
      s1 += p.lq1[i * 64 + d] * p.lk1[i * 64 + d];
      s2 += p.lq2[i * 64 + d] * p.lk2[i * 64 + d];
    }
    const float li = 0.8f - 0.6f * expf(-0.3f * (float)(2 * i));
    p.lam()[i] = expf(s1) - expf(s2) + li;
    p.lam()[2 + i] = li;
  }
  {
    float (*tile)[65] = (float (*)[65])smem;
    constexpr int T_IE = 16 * (EVEN_IN / 64), T_O = 16 * (D / 64), T_IO = 16 * (ODD_IN / 64), T_Q = 16 * (2048 / 64);
    constexpr int T_PAIR = T_IE + T_O + T_IO + T_O;
    constexpr int T_ALL = 2 * T_PAIR + DEPTH * T_Q;
    for (int t = bid_; t < T_ALL; t += gridDim.x) {
      const float* src_m; bf16_t* dst_m; int N, lt;
      if (t < 2 * T_PAIR) {
        const int i = t / T_PAIR; lt = t % T_PAIR;
        if (lt < T_IE) { src_m = p.w_in_even + (size_t)i * D * EVEN_IN; dst_m = p.w_in_even_t() + (size_t)i * D * EVEN_IN; N = EVEN_IN; }
        else if (lt < T_IE + T_O) { lt -= T_IE; src_m = p.w_out_even + (size_t)i * D * D; dst_m = p.w_out_even_t() + (size_t)i * D * D; N = D; }
        else if (lt < T_IE + T_O + T_IO) { lt -= T_IE + T_O; src_m = p.w_in_odd + (size_t)i * D * ODD_IN; dst_m = p.w_in_odd_t() + (size_t)i * D * ODD_IN; N = ODD_IN; }
        else { lt -= T_IE + T_O + T_IO; src_m = p.w_out_odd + (size_t)i * D * D; dst_m = p.w_out_odd_t() + (size_t)i * D * D; N = D; }
      } else {
        const int l = (t - 2 * T_PAIR) / T_Q; lt = (t - 2 * T_PAIR) % T_Q;
        src_m = p.wq + (size_t)l * D * 2048; dst_m = p.wq_t() + (size_t)l * D * 2048; N = 2048;
      }
      const int tn_cnt = N / 64, tk = lt / tn_cnt, tn = lt % tn_cnt;
#pragma unroll 4
      for (int i = 0; i < 16; ++i) {
        const int idx = tid + i * 256, kk = idx >> 6, nn = idx & 63;
        tile[kk][nn] = src_m[(size_t)(tk * 64 + kk) * N + tn * 64 + nn];
      }
      __syncthreads();
#pragma unroll 4
      for (int i = 0; i < 16; ++i) {
        const int idx = tid + i * 256, nn = idx >> 6, kk = idx & 63;
        dst_m[(size_t)(tn * 64 + nn) * D + tk * 64 + kk] = f2bf(tile[kk][nn]);
      }
      __syncthreads();
    }
  }
#if !FUSED_TOPK
  for (int q = 0; q < DEPTH * 16; ++q) transpose_convert<float>(p.subk + (size_t)q * 128 * 128, p.dtmp() + (size_t)q * 128 * 128, 128, 128, smem, tid_, bid_);
#endif
  for (int i = bid_ * NTHR + tid; i < DEPTH * 16 * 128 * 128 / 4; i += gridDim.x * NTHR) {
    const float4 a = ((const float4*)p.subk)[i];
    ((uint2*)p.subkT())[i] = make_uint2(pack2(a.x, a.y), pack2(a.z, a.w));
    const float lx = a.x - bf2f(f2bf(a.x)), ly = a.y - bf2f(f2bf(a.y)), lz = a.z - bf2f(f2bf(a.z)), lw = a.w - bf2f(f2bf(a.w));
    ((uint2*)p.subkT())[(size_t)(DEPTH * 16 * 128 * 128 / 4) + i] = make_uint2(pack2(lx, ly), pack2(lz, lw));
  }
  {
    uint4* z4 = (uint4*)(p.ws + OFF_xcur);
    const size_t n16 = (OFF_bar - OFF_xcur) / 16;
    for (size_t i = (size_t)bid_ * NTHR + tid; i < n16; i += (size_t)gridDim.x * NTHR) z4[i] = make_uint4(0u, 0u, 0u, 0u);
  }
  {
    const size_t n4 = (size_t)DEPTH * NEXP * D / 4;
    for (size_t i = (size_t)bid_ * NTHR + tid; i < n4; i += (size_t)gridDim.x * NTHR) {
      const float4 a = ((const float4*)p.pu)[i];
      const float4 b = ((const float4*)p.pv)[i];
      int ua = __builtin_amdgcn_cvt_pk_fp8_f32(a.x * U_SCALE, a.y * U_SCALE, 0, false);
      ua = __builtin_amdgcn_cvt_pk_fp8_f32(a.z * U_SCALE, a.w * U_SCALE, ua, true);
      int vb_ = __builtin_amdgcn_cvt_pk_fp8_f32(b.x * V_SCALE, b.y * V_SCALE, 0, false);
      vb_ = __builtin_amdgcn_cvt_pk_fp8_f32(b.z * V_SCALE, b.w * V_SCALE, vb_, true);
      ((int*)p.u_bf())[i] = ua;
      ((int*)p.v_bf())[i] = vb_;
    }
  }
}

DI void phase_ln_mod(const Params& p, const float* __restrict__ src, bool do_ln, const float* __restrict__ g, const float* __restrict__ bb,
                     float* __restrict__ dstx, const float* __restrict__ modbase  , bf16_t* __restrict__ dsth, int tid_, int bid_) {
  const int lane = tid_ & 63, wave = tid_ >> 6;
  const int rstride = gridDim.x * 4;
  float4 vn[4];
  {
    const int row0 = min(bid_ * 4 + wave, M - 1);
#pragma unroll
    for (int j = 0; j < 4; ++j) vn[j] = *(const float4*)(src + (size_t)row0 * D + j * 256 + lane * 4);
  }
  for (int row = bid_ * 4 + wave; row < M; row += rstride) {
    const int b = row / S;
    float4 v[4];
#pragma unroll
    for (int j = 0; j < 4; ++j) v[j] = vn[j];
    {
      const int nrow = min(row + rstride, M - 1);
#pragma unroll
      for (int j = 0; j < 4; ++j) vn[j] = *(const float4*)(src + (size_t)nrow * D + j * 256 + lane * 4);
    }
    if (do_ln) {
      float s = 0.f;
#pragma unroll
      for (int j = 0; j < 4; ++j) s += v[j].x + v[j].y + v[j].z + v[j].w;
      const float mu = wave_sum(s) * (1.0f / D);
      float q = 0.f;
#pragma unroll
      for (int j = 0; j < 4; ++j) {
        v[j].x -= mu; v[j].y -= mu; v[j].z -= mu; v[j].w -= mu;
        q += v[j].x * v[j].x + v[j].y * v[j].y + v[j].z * v[j].z + v[j].w * v[j].w;
      }
      const float rstd = rsqrtf(wave_sum(q) * (1.0f / D) + LN_EPS);
#pragma unroll
      for (int j = 0; j < 4; ++j) {
        const float4 gg = *(const float4*)(g + j * 256 + lane * 4);
        const float4 be = *(const float4*)(bb + j * 256 + lane * 4);
        v[j].x = v[j].x * rstd * gg.x + be.x; v[j].y = v[j].y * rstd * gg.y + be.y;
        v[j].z = v[j].z * rstd * gg.z + be.z; v[j].w = v[j].w * rstd * gg.w + be.w;
        if (dstx) *(float4*)(dstx + (size_t)row * D + j * 256 + lane * 4) = v[j];
      }
    }
    const float* mb = modbase + (size_t)b * 3072;
#pragma unroll
    for (int j = 0; j < 4; ++j) {
      const float4 sh = *(const float4*)(mb + j * 256 + lane * 4);
      const float4 sc = *(const float4*)(mb + D + j * 256 + lane * 4);
      float h0 = v[j].x * (1.f + sc.x) + sh.x, h1 = v[j].y * (1.f + sc.y) + sh.y;
      float h2 = v[j].z * (1.f + sc.z) + sh.z, h3 = v[j].w * (1.f + sc.w) + sh.w;
      *(uint2*)(dsth + (size_t)row * D + j * 256 + lane * 4) = make_uint2(pack2_hw(h0, h1), pack2_hw(h2, h3));
    }
  }
}


DI void topk_from_sQ(const Params& p, int layer, int tn, int m0, char* smem, int tid, int wm, int wn, int r, int h) {
  constexpr int QS = 136;
  const bf16_t* sQh = (const bf16_t*)smem;
  const bf16_t* sQl = sQh + 128 * QS;
  f32x16 acc[2][2];
  const bf16_t* kh = (const bf16_t*)p.subkT() + (size_t)(layer * 16 + tn) * 128 * 128;
  const bf16_t* kl = kh + (size_t)DEPTH * 16 * 128 * 128;
#pragma unroll
  for (int a = 0; a < 2; ++a)
#pragma unroll
    for (int b = 0; b < 2; ++b)
#pragma unroll
      for (int i = 0; i < 16; ++i) acc[a][b][i] = 0.f;
#pragma unroll 2
  for (int ks = 0; ks < 8; ++ks) {
    bf16x8 khf[2], klf[2], qhf[2], qlf[2];
#pragma unroll
    for (int i = 0; i < 2; ++i) {
      const size_t ko = (size_t)(wm * 64 + i * 32 + r) * 128 + ks * 16 + h * 8;
      khf[i] = *(const bf16x8*)(kh + ko);
      klf[i] = *(const bf16x8*)(kl + ko);
      const int qo = (wn * 64 + i * 32 + r) * QS + ks * 16 + h * 8;
      qhf[i] = *(const bf16x8*)(sQh + qo);
      qlf[i] = *(const bf16x8*)(sQl + qo);
    }
#pragma unroll
    for (int a = 0; a < 2; ++a)
#pragma unroll
      for (int b = 0; b < 2; ++b) {
        acc[a][b] = __builtin_amdgcn_mfma_f32_32x32x16_bf16(klf[a], qhf[b], acc[a][b], 0, 0, 0);
        acc[a][b] = __builtin_amdgcn_mfma_f32_32x32x16_bf16(khf[a], qlf[b], acc[a][b], 0, 0, 0);
        acc[a][b] = __builtin_amdgcn_mfma_f32_32x32x16_bf16(khf[a], qhf[b], acc[a][b], 0, 0, 0);
      }
  }
  unsigned* sM = (unsigned*)smem;
  __syncthreads();
#pragma unroll
  for (int b = 0; b < 2; ++b) {
    unsigned v[32];
#pragma unroll
    for (int a = 0; a < 2; ++a)
#pragma unroll
      for (int i = 0; i < 16; ++i) {
        const int n = wm * 64 + a * 32 + (i & 3) + 8 * (i >> 2) + 4 * h;
        v[a * 16 + i] = (ordkey(acc[a][b][i]) & ~127u) | (unsigned)(127 - n);
      }
#pragma unroll
    for (int k = 2; k <= 32; k <<= 1)
#pragma unroll
      for (int j = k >> 1; j > 0; j >>= 1)
#pragma unroll
        for (int i = 0; i < 32; ++i) {
          const int l = i ^ j;
          if (l > i) {
            const unsigned x = v[i], y = v[l];
            const bool desc = ((i & k) == 0);
            v[i] = desc ? max(x, y) : min(x, y);
            v[l] = desc ? min(x, y) : max(x, y);
          }
        }
    unsigned* dst = sM + (wn * 64 + b * 32 + r) * 68 + (wm * 2 + h) * 16;
#pragma unroll
    for (int q4 = 0; q4 < 4; ++q4) *(uint4*)(dst + q4 * 4) = make_uint4(v[q4 * 4], v[q4 * 4 + 1], v[q4 * 4 + 2], v[q4 * 4 + 3]);
    __builtin_amdgcn_sched_barrier(0);
  }
  __syncthreads();
  if (tid < 128) {
    const unsigned* L = sM + tid * 68;
    int p0 = 0, p1 = 16, p2 = 32, p3 = 48;
    unsigned h0 = L[0], h1 = L[16], h2 = L[32], h3 = L[48];
    const size_t ob = ((size_t)(m0 + tid) * 16 + tn) * 16;
    float ov[16];
    int oi[16];
#pragma unroll
    for (int j = 0; j < 16; ++j) {
      const unsigned mx = max(max(h0, h1), max(h2, h3));
      ov[j] = unordkey(mx & ~127u);
      oi[j] = 127 - (int)(mx & 127u);
      const bool s0 = (mx == h0), s1 = (mx == h1), s2 = (mx == h2), s3 = (mx == h3);
      p0 += s0; p1 += s1; p2 += s2; p3 += s3;
      const int pa = s0 ? p0 : (s1 ? p1 : (s2 ? p2 : p3));
      const int lim = s0 ? 16 : (s1 ? 32 : (s2 ? 48 : 64));
      const unsigned nv = L[min(pa, 63)];
      const unsigned nh = (pa < lim) ? nv : 0u;
      h0 = s0 ? nh : h0; h1 = s1 ? nh : h1; h2 = s2 ? nh : h2; h3 = s3 ? nh : h3;
    }
#pragma unroll
    for (int q4 = 0; q4 < 4; ++q4) {
      *(float4*)(p.sv() + ob + q4 * 4) = make_float4(ov[q4 * 4], ov[q4 * 4 + 1], ov[q4 * 4 + 2], ov[q4 * 4 + 3]);
      *(int4*)(p.si() + ob + q4 * 4) = make_int4(oi[q4 * 4], oi[q4 * 4 + 1], oi[q4 * 4 + 2], oi[q4 * 4 + 3]);
    }
  }

}


DI void phase_topk_mfma(const Params& p, int layer, char* smem, int tid_, int bid_) {
  constexpr int QS = 136;
  bf16_t* sQ = (bf16_t*)smem;
  const bf16_t* qb = (const bf16_t*)p.qpeer();
  const int tid = tid_, lane = tid & 63, wave = tid >> 6;
  const int wm = wave >> 1, wn = wave & 1, r = lane & 31, h = lane >> 5;
  for (int t = bid_; t < (M / 128) * 16; t += gridDim.x) {
    const int tm = t >> 4, tn = t & 15, m0 = tm * 128;
    __syncthreads();
#pragma unroll
    for (int i = 0; i < 8; ++i) {
      const int c = tid + i * 256;
      *(uint4*)(sQ + (c >> 4) * QS + (c & 15) * 8) = *(const uint4*)(qb + (size_t)(m0 + (c >> 4)) * 2048 + tn * 128 + (c & 15) * 8);
    }
    __syncthreads();
    topk_from_sQ(p, layer, tn, m0, smem, tid, wm, wn, r, h);
  }
}

enum { EPI_EVEN = 0, EPI_ODD = 1, EPI_OUT = 2, EPI_Q = 3 };
constexpr int LDA = 72;

template <int EPI>
DI void phase_gemm(const Params& p, const bf16_t* __restrict__ A, const bf16_t* __restrict__ Bt, int N, int layer, const float* __restrict__ xres,
                   char* smem, int tid_, int bid_) {
  constexpr int K = D;
  bf16_t* sA = (bf16_t*)smem;
  bf16_t* sB = sA + 128 * LDA;
  const int tid = tid_, lane = tid & 63, wave = tid >> 6;
  const int wm = wave >> 1, wn = wave & 1, r = lane & 31, h = lane >> 5;
  const int tn_cnt = N / 128, ntile = (M / 128) * tn_cnt;
  const int per_x = ntile >> 3;
  for (int l = bid_ >> 3; l < per_x; l += (int)(gridDim.x >> 3)) {
    const int t = (bid_ & 7) * per_x + l;
    const int tm = t / tn_cnt, tn = t % tn_cnt;
    const int m0 = tm * 128, n0 = tn * 128;
    f32x16 acc[2][2];
#pragma unroll
    for (int a = 0; a < 2; ++a)
#pragma unroll
      for (int b = 0; b < 2; ++b)
#pragma unroll
        for (int i = 0; i < 16; ++i) acc[a][b][i] = 0.f;
    const int c0 = tid, c1 = tid + 256, c2 = tid + 512, c3 = tid + 768;
    const bf16_t* ga0 = A + (size_t)(m0 + (c0 >> 3)) * K + (c0 & 7) * 8;
    const bf16_t* ga1 = A + (size_t)(m0 + (c1 >> 3)) * K + (c1 & 7) * 8;
    const bf16_t* ga2 = A + (size_t)(m0 + (c2 >> 3)) * K + (c2 & 7) * 8;
    const bf16_t* ga3 = A + (size_t)(m0 + (c3 >> 3)) * K + (c3 & 7) * 8;
    const bf16_t* gb0 = Bt + (size_t)(n0 + (c0 >> 3)) * K + (c0 & 7) * 8;
    const bf16_t* gb1 = Bt + (size_t)(n0 + (c1 >> 3)) * K + (c1 & 7) * 8;
    const bf16_t* gb2 = Bt + (size_t)(n0 + (c2 >> 3)) * K + (c2 & 7) * 8;
    const bf16_t* gb3 = Bt + (size_t)(n0 + (c3 >> 3)) * K + (c3 & 7) * 8;
    uint4 ra0 = *(const uint4*)ga0, ra1 = *(const uint4*)ga1, ra2 = *(const uint4*)ga2, ra3 = *(const uint4*)ga3;
    uint4 rb0 = *(const uint4*)gb0, rb1 = *(const uint4*)gb1, rb2 = *(const uint4*)gb2, rb3 = *(const uint4*)gb3;
    for (int kt = 0; kt < K / 64; ++kt) {
      __syncthreads();
      *(uint4*)(sA + (c0 >> 3) * LDA + (c0 & 7) * 8) = ra0;
      *(uint4*)(sA + (c1 >> 3) * LDA + (c1 & 7) * 8) = ra1;
      *(uint4*)(sA + (c2 >> 3) * LDA + (c2 & 7) * 8) = ra2;
      *(uint4*)(sA + (c3 >> 3) * LDA + (c3 & 7) * 8) = ra3;
      *(uint4*)(sB + (c0 >> 3) * LDA + (c0 & 7) * 8) = rb0;
      *(uint4*)(sB + (c1 >> 3) * LDA + (c1 & 7) * 8) = rb1;
      *(uint4*)(sB + (c2 >> 3) * LDA + (c2 & 7) * 8) = rb2;
      *(uint4*)(sB + (c3 >> 3) * LDA + (c3 & 7) * 8) = rb3;
      __syncthreads();
      if (kt + 1 < K / 64) {
        const int k0 = (kt + 1) * 64;
        ra0 = *(const uint4*)(ga0 + k0); ra1 = *(const uint4*)(ga1 + k0); ra2 = *(const uint4*)(ga2 + k0); ra3 = *(const uint4*)(ga3 + k0);
        rb0 = *(const uint4*)(gb0 + k0); rb1 = *(const uint4*)(gb1 + k0); rb2 = *(const uint4*)(gb2 + k0); rb3 = *(const uint4*)(gb3 + k0);
      }
#pragma unroll
      for (int ks = 0; ks < 4; ++ks) {
        bf16x8 fa[2], fb[2];
#pragma unroll
        for (int i = 0; i < 2; ++i) {
          fa[i] = *(const bf16x8*)(sA + (wm * 64 + i * 32 + r) * LDA + ks * 16 + h * 8);
          fb[i] = *(const bf16x8*)(sB + (wn * 64 + i * 32 + r) * LDA + ks * 16 + h * 8);
        }
#pragma unroll
        for (int a = 0; a < 2; ++a)
#pragma unroll
          for (int b = 0; b < 2; ++b) {
            if (EPI == EPI_Q) acc[a][b] = __builtin_amdgcn_mfma_f32_32x32x16_bf16(fb[b], fa[a], acc[a][b], 0, 0, 0);
            else acc[a][b] = __builtin_amdgcn_mfma_f32_32x32x16_bf16(fa[a], fb[b], acc[a][b], 0, 0, 0);
          }
      }
    }
    const int nb0 = n0 + wn * 64;
    if (EPI == EPI_EVEN || EPI == EPI_ODD) {
      const bool rope = (EPI == EPI_EVEN) ? (nb0 >= 1536 && nb0 < 2560) : (nb0 < 1280);
      const bool is_v = (EPI == EPI_EVEN) ? ((nb0 >= 1024 && nb0 < 1536) || nb0 >= 2560) : (nb0 >= 1280);
      if (!is_v)
#pragma unroll
      for (int mi = 0; mi < 2; ++mi)
#pragma unroll
        for (int i = 0; i < 16; ++i) {
          const int m = m0 + wm * 64 + mi * 32 + (i & 3) + 8 * (i >> 2) + 4 * h;
          float t1 = acc[mi][0][i], t2 = acc[mi][1][i];
          if (rope) {
            const int pos = m & (S - 1);
            const float cs = p.ropec()[pos * 32 + r], sn = p.ropes()[pos * 32 + r];
            const float o1 = t1 * cs - t2 * sn, o2 = t1 * sn + t2 * cs;
            t1 = o1; t2 = o2;
          }
          const unsigned pk = pack2_hw(t1, t2);
          p.proj()[(size_t)m * N + nb0 + r] = (bf16_t)(pk & 0xffffu);
          p.proj()[(size_t)m * N + nb0 + 32 + r] = (bf16_t)(pk >> 16);
        }
      int nv0 = -1;
      if (EPI == EPI_EVEN) { if (nb0 >= 1024 && nb0 < 1536) nv0 = nb0 - 1024; else if (nb0 >= 2560) nv0 = nb0 - 2560 + 512; }
      else { if (nb0 >= 1280) nv0 = nb0 - 1280; }
      if (nv0 >= 0) {
#pragma unroll
        for (int mi = 0; mi < 2; ++mi)
#pragma unroll
          for (int ni = 0; ni < 2; ++ni)
#pragma unroll
            for (int g4 = 0; g4 < 4; ++g4) {
              const int m = m0 + wm * 64 + mi * 32 + 8 * g4 + 4 * h;
              const int b = m / S, s = m & (S - 1);
              *(uint2*)(p.vT() + ((size_t)b * 1024 + nv0 + ni * 32 + r) * S + s) =
                  make_uint2(pack2_hw(acc[mi][ni][g4 * 4 + 0], acc[mi][ni][g4 * 4 + 1]), pack2_hw(acc[mi][ni][g4 * 4 + 2], acc[mi][ni][g4 * 4 + 3]));
            }
      }
    } else if (EPI == EPI_OUT) {
      float gate_ni[2];
#pragma unroll
      for (int ni = 0; ni < 2; ++ni) gate_ni[ni] = p.mods()[((size_t)(layer * 2 + 0) * 2 + (m0 / S)) * 3072 + 2 * D + nb0 + ni * 32 + r];
#pragma unroll
      for (int mi = 0; mi < 2; ++mi)
#pragma unroll
        for (int ni = 0; ni < 2; ++ni)
#pragma unroll
          for (int i = 0; i < 16; ++i) {
            const int m = m0 + wm * 64 + mi * 32 + (i & 3) + 8 * (i >> 2) + 4 * h;
            const int n = nb0 + ni * 32 + r;
            p.zbuf()[(size_t)m * D + n] = ALPHA * xres[(size_t)m * D + n] + gate_ni[ni] * acc[mi][ni][i];
          }
    } else {
#if !FUSED_TOPK
#pragma unroll
      for (int a = 0; a < 2; ++a)
#pragma unroll
        for (int b = 0; b < 2; ++b)
#pragma unroll
          for (int i = 0; i < 16; ++i)
            p.qpeer()[(size_t)(m0 + wm * 64 + a * 32 + r) * 2048 + n0 + wn * 64 + b * 32 + (i & 3) + 8 * (i >> 2) + 4 * h] = acc[a][b][i];
      if (false) {
#else
      {
#endif
#if TOPK_SEPARATE
      {
        bf16_t* qb = (bf16_t*)p.qpeer();
#pragma unroll
        for (int a = 0; a < 2; ++a)
#pragma unroll
          for (int b = 0; b < 2; ++b)
#pragma unroll
            for (int g4 = 0; g4 < 4; ++g4)
              *(uint2*)(qb + (size_t)(m0 + wm * 64 + a * 32 + r) * 2048 + n0 + wn * 64 + b * 32 + 8 * g4 + 4 * h) =
                  make_uint2(pack2_hw(acc[a][b][g4 * 4 + 0], acc[a][b][g4 * 4 + 1]), pack2_hw(acc[a][b][g4 * 4 + 2], acc[a][b][g4 * 4 + 3]));
      }
      if (false) {
#else
      {
#endif
      constexpr int QS = 136;
      bf16_t* sQh = (bf16_t*)smem;
      bf16_t* sQl = sQh + 128 * QS;
      __syncthreads();
#pragma unroll
      for (int a = 0; a < 2; ++a)
#pragma unroll
        for (int b = 0; b < 2; ++b)
#pragma unroll
          for (int g4 = 0; g4 < 4; ++g4) {
            const float v0 = acc[a][b][g4 * 4 + 0], v1 = acc[a][b][g4 * 4 + 1], v2 = acc[a][b][g4 * 4 + 2], v3 = acc[a][b][g4 * 4 + 3];
            const unsigned h01 = pack2_hw(v0, v1), h23 = pack2_hw(v2, v3);
            const int off = (wm * 64 + a * 32 + r) * QS + wn * 64 + b * 32 + 8 * g4 + 4 * h;
            *(uint2*)(sQh + off) = make_uint2(h01, h23);
            *(uint2*)(sQl + off) = make_uint2(pack2_hw(v0 - bflo(h01), v1 - bfhi(h01)), pack2_hw(v2 - bflo(h23), v3 - bfhi(h23)));
          }
      __syncthreads();
      topk_from_sQ(p, layer, tn, m0, smem, tid, wm, wn, r, h);
      }
      }
    }
  }
}

struct OnlineSm {
  float m, l;
};

template <typename KeyFn>
DI void naive_attn_thread(const bf16_t* __restrict__ qptr, float m_init, float l_init, int nkeys, KeyFn keyfn, bf16_t* __restrict__ optr) {
  float q[64], acc[64];
#pragma unroll
  for (int c = 0; c < 8; ++c) {
    const uint4 u = *(const uint4*)(qptr + c * 8);
    q[c * 8 + 0] = bflo(u.x); q[c * 8 + 1] = bfhi(u.x); q[c * 8 + 2] = bflo(u.y); q[c * 8 + 3] = bfhi(u.y);
    q[c * 8 + 4] = bflo(u.z); q[c * 8 + 5] = bfhi(u.z); q[c * 8 + 6] = bflo(u.w); q[c * 8 + 7] = bfhi(u.w);
  }
#pragma unroll
  for (int d = 0; d < 64; ++d) acc[d] = 0.f;
  float mx = m_init, l = l_init;
  for (int kk = 0; kk < nkeys; ++kk) {
    const bf16_t *kp, *vp;
    float bias;
    bool valid;
    keyfn(kk, kp, vp, bias, valid);
    if (!valid) continue;
    float s = 0.f;
#pragma unroll
    for (int c = 0; c < 8; ++c) {
      const uint4 u = *(const uint4*)(kp + c * 8);
      s += q[c * 8 + 0] * bflo(u.x) + q[c * 8 + 1] * bfhi(u.x) + q[c * 8 + 2] * bflo(u.y) + q[c * 8 + 3] * bfhi(u.y) +
           q[c * 8 + 4] * bflo(u.z) + q[c * 8 + 5] * bfhi(u.z) + q[c * 8 + 6] * bflo(u.w) + q[c * 8 + 7] * bfhi(u.w);
    }
    s = s * 0.125f + bias;
    const float mn = fmaxf(mx, s);
    const float corr = __expf(mx - mn), pe = __expf(s - mn);
    l = l * corr + pe;
#pragma unroll
    for (int c = 0; c < 8; ++c) {
      const uint4 u = *(const uint4*)(vp + c * 8);
      acc[c * 8 + 0] = acc[c * 8 + 0] * corr + pe * bflo(u.x); acc[c * 8 + 1] = acc[c * 8 + 1] * corr + pe * bfhi(u.x);
      acc[c * 8 + 2] = acc[c * 8 + 2] * corr + pe * bflo(u.y); acc[c * 8 + 3] = acc[c * 8 + 3] * corr + pe * bfhi(u.y);
      acc[c * 8 + 4] = acc[c * 8 + 4] * corr + pe * bflo(u.z); acc[c * 8 + 5] = acc[c * 8 + 5] * corr + pe * bfhi(u.z);
      acc[c * 8 + 6] = acc[c * 8 + 6] * corr + pe * bflo(u.w); acc[c * 8 + 7] = acc[c * 8 + 7] * corr + pe * bfhi(u.w);
    }
    mx = mn;
  }
  const float inv = 1.0f / l;
#pragma unroll
  for (int c = 0; c < 8; ++c) {
    uint4 u;
    u.x = pack2(acc[c * 8 + 0] * inv, acc[c * 8 + 1] * inv); u.y = pack2(acc[c * 8 + 2] * inv, acc[c * 8 + 3] * inv);
    u.z = pack2(acc[c * 8 + 4] * inv, acc[c * 8 + 5] * inv); u.w = pack2(acc[c * 8 + 6] * inv, acc[c * 8 + 7] * inv);
    *(uint4*)(optr + c * 8) = u;
  }
}

DI void phase_attn_even_naive(const Params& p, int li, int tid_, int bid_) {
  const int tid = tid_;
  for (int tile = bid_; tile < M * 8 / NTHR; tile += gridDim.x) {
    const int idx = tile * NTHR + tid;
    const int head = idx & 7, token = idx >> 3;
    const int b = token / S, s = token & (S - 1), r = s >> 6, c = s & 63;
    const int rs = min(max(r - 4, 0), 128 - 8), csx = min(max(c - 8, 0), 64 - 16);
    const bf16_t* base = p.proj() + (size_t)b * S * EVEN_IN;
    const float* rp = p.rpb + (size_t)(li * 8 + head) * 15 * 31;
    auto keyfn = [&](int kk, const bf16_t*& kp, const bf16_t*& vp, float& bias, bool& valid) {
      const int kr = rs + (kk >> 4), kc = csx + (kk & 15);
      const size_t off = (size_t)(kr * 64 + kc) * EVEN_IN;
      kp = base + off + 512 + head * 64;
      vp = base + off + 1024 + head * 64;
      bias = rp[(kr - r + 7) * 31 + (kc - c + 15)];
      valid = true;
    };
    naive_attn_thread(p.proj() + (size_t)token * EVEN_IN + head * 64, -1e30f, 0.f, 128, keyfn, p.obuf() + (size_t)token * D + head * 64);
  }
  for (int tile = bid_; tile < (M / NTHR) * 32; tile += gridDim.x) {
    const int tt = tile >> 5, sub = tile & 31;
    const int hh = sub >> 3, mm = (sub >> 2) & 1, qt = sub & 3;
    const int token = tt * NTHR + tid;
    const int b = token / S;
    const bf16_t* base = p.proj() + (size_t)b * S * EVEN_IN;
    float q[64], acc[32];
    const bf16_t* qptr = p.proj() + (size_t)token * EVEN_IN + 1536 + hh * 128 + mm * 64;
#pragma unroll
    for (int c = 0; c < 8; ++c) {
      const uint4 u = *(const uint4*)(qptr + c * 8);
      q[c * 8 + 0] = bflo(u.x); q[c * 8 + 1] = bfhi(u.x); q[c * 8 + 2] = bflo(u.y); q[c * 8 + 3] = bfhi(u.y);
      q[c * 8 + 4] = bflo(u.z); q[c * 8 + 5] = bfhi(u.z); q[c * 8 + 6] = bflo(u.w); q[c * 8 + 7] = bfhi(u.w);
    }
#pragma unroll
    for (int d = 0; d < 32; ++d) acc[d] = 0.f;
    float mx = -1e30f, l = 0.f;
    for (int key = 0; key < S; ++key) {
      const bf16_t* kp = base + (size_t)key * EVEN_IN + 2048 + hh * 128 + mm * 64;
      const bf16_t* vp = base + (size_t)key * EVEN_IN + 2560 + hh * 128 + qt * 32;
      float sdot = 0.f;
#pragma unroll
      for (int c = 0; c < 8; ++c) {
        const uint4 u = *(const uint4*)(kp + c * 8);
        sdot += q[c * 8 + 0] * bflo(u.x) + q[c * 8 + 1] * bfhi(u.x) + q[c * 8 + 2] * bflo(u.y) + q[c * 8 + 3] * bfhi(u.y) +
                q[c * 8 + 4] * bflo(u.z) + q[c * 8 + 5] * bfhi(u.z) + q[c * 8 + 6] * bflo(u.w) + q[c * 8 + 7] * bfhi(u.w);
      }
      sdot *= 0.125f;
      const float mn = fmaxf(mx, sdot);
      const float corr = __expf(mx - mn), pe = __expf(sdot - mn);
      l = l * corr + pe;
#pragma unroll
      for (int c = 0; c < 4; ++c) {
        const uint4 u = *(const uint4*)(vp + c * 8);
        acc[c * 8 + 0] = acc[c * 8 + 0] * corr + pe * bflo(u.x); acc[c * 8 + 1] = acc[c * 8 + 1] * corr + pe * bfhi(u.x);
        acc[c * 8 + 2] = acc[c * 8 + 2] * corr + pe * bflo(u.y); acc[c * 8 + 3] = acc[c * 8 + 3] * corr + pe * bfhi(u.y);
        acc[c * 8 + 4] = acc[c * 8 + 4] * corr + pe * bflo(u.z); acc[c * 8 + 5] = acc[c * 8 + 5] * corr + pe * bfhi(u.z);
        acc[c * 8 + 6] = acc[c * 8 + 6] * corr + pe * bflo(u.w); acc[c * 8 + 7] = acc[c * 8 + 7] * corr + pe * bfhi(u.w);
      }
      mx = mn;
    }
    const float inv = 1.0f / l;
    float* op = p.dtmp() + (((size_t)mm * M + token) * 4 + hh) * 128 + qt * 32;
#pragma unroll
    for (int d = 0; d < 32; d += 4) *(float4*)(op + d) = make_float4(acc[d] * inv, acc[d + 1] * inv, acc[d + 2] * inv, acc[d + 3] * inv);
  }
}

DI void phase_diff_combine(const Params& p, int li, int tid_, int bid_) {
  const float lam = p.lam()[li], linit = p.lam()[2 + li];
  for (int idx = bid_ * NTHR + tid_; idx < M * 4; idx += gridDim.x * NTHR) {
    const int token = idx >> 2, hh = idx & 3;
    const float* o0 = p.dtmp() + ((size_t)token * 4 + hh) * 128;
    const float* o1 = p.dtmp() + (((size_t)M + token) * 4 + hh) * 128;
    float ss = 0.f;
    for (int d = 0; d < 128; ++d) {
      const float o = o0[d] - lam * o1[d];
      ss += o * o;
    }
    const float rs = rsqrtf(ss * (1.0f / 128.f) + LN_EPS) * (1.0f - linit);
    bf16_t* op = p.obuf() + (size_t)token * D + 512 + hh * 128;
    for (int d = 0; d < 128; ++d) {
      const float o = o0[d] - lam * o1[d];
      op[d] = f2bf(o * rs * p.sub_g[li * 128 + d]);
    }
  }
}

DI void phase_attn_odd_naive(const Params& p, int lj, int tid_, int bid_) {
  const int tid = tid_;
  for (int tile = bid_; tile < M * 16 / NTHR; tile += gridDim.x) {
    const int idx = tile * NTHR + tid;
    const int head = idx & 15, token = idx >> 4;
    const int b = token / S, s = token & (S - 1);
    const int k_lo = max(s - 128, 0), k_hi = min(s + 128, S - 1);
    const bf16_t* base = p.proj() + (size_t)b * S * ODD_IN;
    const int kvh = head >> 2;
    auto keyfn = [&](int kk, const bf16_t*& kp, const bf16_t*& vp, float& bias, bool& valid) {
      const size_t off = (size_t)(k_lo + kk) * ODD_IN;
      kp = base + off + 1024 + kvh * 64;
      vp = base + off + 1280 + kvh * 64;
      bias = 0.f;
      valid = true;
    };
    naive_attn_thread(p.proj() + (size_t)token * ODD_IN + head * 64, p.sink[lj * 16 + head], 1.0f, k_hi - k_lo + 1, keyfn,
                      p.obuf() + (size_t)token * D + head * 64);
  }
}


#define MFMA32(a, b, c) __builtin_amdgcn_mfma_f32_32x32x16_bf16((a), (b), (c), 0, 0, 0)
constexpr float LOG2E = 1.4426950408889634f;
constexpr int VS = 68;

DI bf16x8 pack8(float a0, float a1, float a2, float a3, float a4, float a5, float a6, float a7) {
  u32x4 pk;
  asm volatile("v_cvt_pk_bf16_f32 %0, %4, %5\n\tv_cvt_pk_bf16_f32 %1, %6, %7\n\tv_cvt_pk_bf16_f32 %2, %8, %9\n\tv_cvt_pk_bf16_f32 %3, %10, %11\n\ts_nop 1"
               : "=&v"(pk[0]), "=&v"(pk[1]), "=&v"(pk[2]), "=&v"(pk[3])
               : "v"(a0), "v"(a1), "v"(a2), "v"(a3), "v"(a4), "v"(a5), "v"(a6), "v"(a7));
  return __builtin_bit_cast(bf16x8, pk);
}

template <int NDT, int KS, bool FOLD = false, typename MaskFn>
DI void attn_tile(const bf16_t* sKw, const bf16_t* sV, const bf16x8 (&qf)[2][4], f32x16 (&o)[2][NDT], float (&mrow)[2], float (&lrow)[2], int r, int h,
                  MaskFn&& mask, float fold_sc = 1.0f) {
#pragma unroll 1
  for (int sub = 0; sub < 2; ++sub) {
    f32x16 s[2];
#pragma unroll
    for (int i = 0; i < 16; ++i) { s[0][i] = 0.f; s[1][i] = 0.f; }
#pragma unroll
    for (int ks = 0; ks < 4; ++ks) {
      const bf16x8 kf = *(const bf16x8*)(sKw + (sub * 32 + r) * KS + ks * 16 + h * 8);
      s[0] = MFMA32(kf, qf[0][ks], s[0]);
      s[1] = MFMA32(kf, qf[1][ks], s[1]);
    }
    bf16x8 pf[2][2];
#pragma unroll
    for (int qt = 0; qt < 2; ++qt) {
      float mx = -INFINITY;
#pragma unroll
      for (int i = 0; i < 16; ++i) {
        const float v = mask(qt, sub, i, s[qt][i]);
        s[qt][i] = v;
        mx = fmaxf(mx, v);
      }
      mx = xhalf_max(mx);
      if (FOLD) mx *= fold_sc;
      const float mn = fmaxf(mrow[qt], mx);
      const float corr = __builtin_amdgcn_exp2f(mrow[qt] - mn);
      mrow[qt] = mn;
      float rs = 0.f;
#pragma unroll
      for (int i = 0; i < 16; ++i) {
        const float pv = __builtin_amdgcn_exp2f(FOLD ? __builtin_fmaf(s[qt][i], fold_sc, -mn) : (s[qt][i] - mn));
        s[qt][i] = pv;
        rs += pv;
      }
      lrow[qt] = lrow[qt] * corr + rs;
      if (__builtin_amdgcn_ballot_w64(corr != 1.0f) != 0ull) {
#pragma unroll
        for (int dt = 0; dt < NDT; ++dt)
#pragma unroll
          for (int i = 0; i < 16; ++i) o[qt][dt][i] *= corr;
      }
      pf[qt][0] = pack8(s[qt][0], s[qt][1], s[qt][2], s[qt][3], s[qt][4], s[qt][5], s[qt][6], s[qt][7]);
      pf[qt][1] = pack8(s[qt][8], s[qt][9], s[qt][10], s[qt][11], s[qt][12], s[qt][13], s[qt][14], s[qt][15]);
    }
#pragma unroll
    for (int sp = 0; sp < 2; ++sp) {
#pragma unroll
      for (int dt = 0; dt < NDT; ++dt) {
        const bf16_t* vp = sV + (dt * 32 + r) * VS + (sub * 2 + sp) * 16 + 4 * h;
        const uint2 lo = *(const uint2*)vp;
        const uint2 hi = *(const uint2*)(vp + 8);
        u32x4 vv; vv[0] = lo.x; vv[1] = lo.y; vv[2] = hi.x; vv[3] = hi.y;
        const bf16x8 vf = __builtin_bit_cast(bf16x8, vv);
        o[0][dt] = MFMA32(vf, pf[0][sp], o[0][dt]);
        o[1][dt] = MFMA32(vf, pf[1][sp], o[1][dt]);
      }
    }
  }
}

DI void lds_put16(bf16_t* dst8, uint4 v) {
  *(uint2*)dst8 = make_uint2(v.x, v.y);
  *(uint2*)(dst8 + 4) = make_uint2(v.z, v.w);
}

DI void phase_diff_mfma(const Params& p, int li, char* smem, int tid_, int bid_) {
  constexpr int KS = 136;
  bf16_t* sK = (bf16_t*)smem;
  bf16_t* sV = sK + 64 * KS;
  const int tid = tid_, lane = tid & 63, wave = tid >> 6, r = lane & 31, h = lane >> 5;
  const int comp = wave & 1, qg = wave >> 1;
  const float sc = 0.125f * LOG2E;
  for (int item = bid_; item < 512; item += gridDim.x) {
    const int bh = item & 7, b = bh >> 2, hh = bh & 3, q0 = (item >> 3) * 128 + qg * 64;
    const bf16_t* kbase = p.proj() + (size_t)b * S * EVEN_IN + 2048 + hh * 128;
    const bf16_t* vbase = p.vT() + ((size_t)b * 1024 + 512 + hh * 128) * S;
    bf16x8 qf[2][4];
    {
    int tq = tid_;
    asm volatile("" : "+v"(tq));
    const int r = tq & 31, h = (tq >> 5) & 1;
#pragma unroll
    for (int qt = 0; qt < 2; ++qt)
#pragma unroll
      for (int ks = 0; ks < 4; ++ks)
        qf[qt][ks] = *(const bf16x8*)(p.proj() + (size_t)(b * S + q0 + qt * 32 + r) * EVEN_IN + 1536 + hh * 128 + comp * 64 + ks * 16 + h * 8);
    }
    f32x16 o[2][4];
#pragma unroll
    for (int a = 0; a < 2; ++a)
#pragma unroll
      for (int d = 0; d < 4; ++d)
#pragma unroll
        for (int i = 0; i < 16; ++i) o[a][d][i] = 0.f;
    float mrow[2] = {-1e30f, -1e30f}, lrow[2] = {0.f, 0.f};
    for (int t = 0; t < S / 64; ++t) {
      int tl = tid;
      asm volatile("" : "+v"(tl));
      const int c0 = tl, c1 = tl + 256, c2 = tl + 512, c3 = tl + 768;
      const bf16_t* kt_ = kbase + (size_t)t * 64 * EVEN_IN;
      const bf16_t* vt_ = vbase + t * 64;
      const uint4 k0 = *(const uint4*)(kt_ + (c0 >> 4) * EVEN_IN + (c0 & 15) * 8);
      const uint4 k1 = *(const uint4*)(kt_ + (c1 >> 4) * EVEN_IN + (c1 & 15) * 8);
      const uint4 k2 = *(const uint4*)(kt_ + (c2 >> 4) * EVEN_IN + (c2 & 15) * 8);
      const uint4 k3 = *(const uint4*)(kt_ + (c3 >> 4) * EVEN_IN + (c3 & 15) * 8);
      const uint4 v0 = *(const uint4*)(vt_ + (c0 >> 3) * S + (c0 & 7) * 8);
      const uint4 v1 = *(const uint4*)(vt_ + (c1 >> 3) * S + (c1 & 7) * 8);
      const uint4 v2 = *(const uint4*)(vt_ + (c2 >> 3) * S + (c2 & 7) * 8);
      const uint4 v3 = *(const uint4*)(vt_ + (c3 >> 3) * S + (c3 & 7) * 8);
      __syncthreads();
      *(uint4*)(sK + (c0 >> 4) * KS + (c0 & 15) * 8) = k0;
      *(uint4*)(sK + (c1 >> 4) * KS + (c1 & 15) * 8) = k1;
      *(uint4*)(sK + (c2 >> 4) * KS + (c2 & 15) * 8) = k2;
      *(uint4*)(sK + (c3 >> 4) * KS + (c3 & 15) * 8) = k3;
      lds_put16(sV + (c0 >> 3) * VS + (c0 & 7) * 8, v0);
      lds_put16(sV + (c1 >> 3) * VS + (c1 & 7) * 8, v1);
      lds_put16(sV + (c2 >> 3) * VS + (c2 & 7) * 8, v2);
      lds_put16(sV + (c3 >> 3) * VS + (c3 & 7) * 8, v3);
      __syncthreads();
      attn_tile<4, KS, true>(sK + comp * 64, sV, qf, o, mrow, lrow, r, h, [&](int, int, int, float raw) { return raw; }, sc);
    }
    int tf = tid_;
    asm volatile("" : "+v"(tf));
    const int lane = tf & 63, r = tf & 31, h = (tf >> 5) & 1;
    const float lam = p.lam()[li], linit = p.lam()[2 + li];
    float inv[2];
#pragma unroll
    for (int qt = 0; qt < 2; ++qt) inv[qt] = 1.0f / xhalf_sum(lrow[qt]);
    float* ex = (float*)smem + qg * 4096;
    float ss[2] = {0.f, 0.f};
#pragma unroll
    for (int pass = 0; pass < 2; ++pass) {
      __syncthreads();
      if (comp == 1) {
#pragma unroll
        for (int qt = 0; qt < 2; ++qt)
#pragma unroll
          for (int d2 = 0; d2 < 2; ++d2)
#pragma unroll
            for (int i = 0; i < 16; ++i) ex[((qt * 2 + d2) * 16 + i) * 64 + lane] = o[qt][pass * 2 + d2][i] * inv[qt];
      }
      __syncthreads();
      if (comp == 0) {
#pragma unroll
        for (int qt = 0; qt < 2; ++qt)
#pragma unroll
          for (int d2 = 0; d2 < 2; ++d2)
#pragma unroll
            for (int i = 0; i < 16; ++i) {
              const float v = o[qt][pass * 2 + d2][i] * inv[qt] - lam * ex[((qt * 2 + d2) * 16 + i) * 64 + lane];
              o[qt][pass * 2 + d2][i] = v;
              ss[qt] += v * v;
            }
      }
    }
    if (comp == 0) {
#pragma unroll
      for (int qt = 0; qt < 2; ++qt) {
        const float tot = xhalf_sum(ss[qt]);
        const float rs = rsqrtf(tot * (1.0f / 128.f) + LN_EPS) * (1.0f - linit);
        bf16_t* op = p.obuf() + (size_t)(b * S + q0 + qt * 32 + r) * D + 512 + hh * 128;
#pragma unroll
        for (int dt = 0; dt < 4; ++dt)
#pragma unroll
          for (int g4 = 0; g4 < 4; ++g4) {
            const int d = dt * 32 + 8 * g4 + 4 * h;
            const float4 sg = *(const float4*)(p.sub_g + li * 128 + d);
            *(uint2*)(op + d) = make_uint2(pack2_hw(o[qt][dt][g4 * 4 + 0] * rs * sg.x, o[qt][dt][g4 * 4 + 1] * rs * sg.y),
                                           pack2_hw(o[qt][dt][g4 * 4 + 2] * rs * sg.z, o[qt][dt][g4 * 4 + 3] * rs * sg.w));
          }
      }
    }
    __syncthreads();
  }
}

constexpr int KS64 = 72;

template <int NDT>
DI void attn64_store_out(const Params& p, f32x16 (&o)[2][NDT], const float (&lrow)[2], int tok0, int col0, int r, int h) {
#pragma unroll
  for (int qt = 0; qt < 2; ++qt) {
    const float inv = 1.0f / xhalf_sum(lrow[qt]);
    bf16_t* op = p.obuf() + (size_t)(tok0 + qt * 32 + r) * D + col0;
#pragma unroll
    for (int dt = 0; dt < NDT; ++dt)
#pragma unroll
      for (int g4 = 0; g4 < 4; ++g4) {
        const int d = dt * 32 + 8 * g4 + 4 * h;
        *(uint2*)(op + d) = make_uint2(pack2_hw(o[qt][dt][g4 * 4 + 0] * inv, o[qt][dt][g4 * 4 + 1] * inv),
                                       pack2_hw(o[qt][dt][g4 * 4 + 2] * inv, o[qt][dt][g4 * 4 + 3] * inv));
      }
  }
}

DI void phase_na_mfma(const Params& p, int li, char* smem, int tid_, int bid_) {
  bf16_t* sK = (bf16_t*)smem;
  bf16_t* sV = sK + 64 * KS64;
  float* sBias = (float*)(sV + 64 * VS);
  const int tid = tid_, lane = tid & 63, wave = tid >> 6, r = lane & 31, h = lane >> 5;
  const float sc = 0.125f * LOG2E;
  for (int item = bid_; item < 2 * 8 * 32; item += gridDim.x) {
    const int bh = item & 15, b = bh >> 3, head = bh & 7, r0 = (item >> 4) * 4;
    const int row = r0 + wave;
    const int rs_w = min(max(row - 4, 0), 120);
    const int kr_lo = min(max(r0 - 4, 0), 120), kr_hi = min(max(r0 + 3 - 4, 0), 120) + 7;
    const bf16_t* kbase = p.proj() + (size_t)b * S * EVEN_IN + 512 + head * 64;
    const bf16_t* vbase = p.vT() + ((size_t)b * 1024 + head * 64) * S;
    __syncthreads();
    for (int i = tid; i < 15 * 32; i += NTHR) {
      const int dr = i >> 5, dc = i & 31;
      sBias[i] = (dc < 31) ? p.rpb[((size_t)(li * 8 + head) * 15 + dr) * 31 + dc] * LOG2E : 0.f;
    }
    bf16x8 qf[2][4];
#pragma unroll
    for (int qt = 0; qt < 2; ++qt)
#pragma unroll
      for (int ks = 0; ks < 4; ++ks)
        qf[qt][ks] = *(const bf16x8*)(p.proj() + (size_t)(b * S + row * 64 + qt * 32 + r) * EVEN_IN + head * 64 + ks * 16 + h * 8);
    f32x16 o[2][2];
#pragma unroll
    for (int a = 0; a < 2; ++a)
#pragma unroll
      for (int d = 0; d < 2; ++d)
#pragma unroll
        for (int i = 0; i < 16; ++i) o[a][d][i] = 0.f;
    float mrow[2] = {-1e30f, -1e30f}, lrow[2] = {0.f, 0.f};
    const int c0 = tid, c1 = tid + 256;
    const bf16_t* gk0 = kbase + (size_t)(c0 >> 3) * EVEN_IN + (c0 & 7) * 8;
    const bf16_t* gk1 = kbase + (size_t)(c1 >> 3) * EVEN_IN + (c1 & 7) * 8;
    const bf16_t* gv0 = vbase + (size_t)(c0 >> 3) * S + (c0 & 7) * 8;
    const bf16_t* gv1 = vbase + (size_t)(c1 >> 3) * S + (c1 & 7) * 8;
    for (int kr = kr_lo; kr <= kr_hi; ++kr) {
      const size_t ko = (size_t)kr * 64 * EVEN_IN;
      const int vo = kr * 64;
      const uint4 k0 = *(const uint4*)(gk0 + ko), k1 = *(const uint4*)(gk1 + ko);
      const uint4 v0 = *(const uint4*)(gv0 + vo), v1 = *(const uint4*)(gv1 + vo);
      __syncthreads();
      *(uint4*)(sK + (c0 >> 3) * KS64 + (c0 & 7) * 8) = k0;
      *(uint4*)(sK + (c1 >> 3) * KS64 + (c1 & 7) * 8) = k1;
      lds_put16(sV + (c0 >> 3) * VS + (c0 & 7) * 8, v0);
      lds_put16(sV + (c1 >> 3) * VS + (c1 & 7) * 8, v1);
      __syncthreads();
      int rr = r, hh2 = h;
      asm volatile("" : "+v"(rr), "+v"(hh2));
      if (kr >= rs_w && kr < rs_w + 8) {
        const float* brow = sBias + (kr - row + 7) * 32;
        attn_tile<2, KS64>(sK, sV, qf, o, mrow, lrow, r, h, [&](int qt, int sub, int i, float raw) {
          const int qc = qt * 32 + rr, kc = sub * 32 + (i & 3) + 8 * (i >> 2) + 4 * hh2;
          const int cs = min(max(qc - 8, 0), 48);
          const bool ok = (kc >= cs) && (kc < cs + 16);
          const int dc = min(max(kc - qc + 15, 0), 30);
          return ok ? raw * sc + brow[dc] : -INFINITY;
        });
      }
    }
    attn64_store_out<2>(p, o, lrow, b * S + row * 64, head * 64, r, h);
  }
}

DI void phase_swa_mfma(const Params& p, int lj, char* smem, int tid_, int bid_) {
  bf16_t* sK = (bf16_t*)smem;
  bf16_t* sV = sK + 64 * KS64;
  const int tid = tid_, lane = tid & 63, wave = tid >> 6, r = lane & 31, h = lane >> 5;
  const float sc = 0.125f * LOG2E;
  for (int item = bid_; item < 2 * 4 * 128; item += gridDim.x) {
    const int bh = item & 7, b = bh >> 2, kvh = bh & 3, qg = item >> 3, q0 = qg * 64;
    const int head = kvh * 4 + wave;
    const int t_lo = max(qg - 2, 0), t_hi = min(qg + 2, S / 64 - 1);
    const bf16_t* kbase = p.proj() + (size_t)b * S * ODD_IN + 1024 + kvh * 64;
    const bf16_t* vbase = p.vT() + ((size_t)b * 1024 + kvh * 64) * S;
    bf16x8 qf[2][4];
#pragma unroll
    for (int qt = 0; qt < 2; ++qt)
#pragma unroll
      for (int ks = 0; ks < 4; ++ks)
        qf[qt][ks] = *(const bf16x8*)(p.proj() + (size_t)(b * S + q0 + qt * 32 + r) * ODD_IN + head * 64 + ks * 16 + h * 8);
    f32x16 o[2][2];
#pragma unroll
    for (int a = 0; a < 2; ++a)
#pragma unroll
      for (int d = 0; d < 2; ++d)
#pragma unroll
        for (int i = 0; i < 16; ++i) o[a][d][i] = 0.f;
    const float sk = p.sink[lj * 16 + head] * LOG2E;
    float mrow[2] = {sk, sk}, lrow[2] = {h == 0 ? 1.f : 0.f, h == 0 ? 1.f : 0.f};
    const int c0 = tid, c1 = tid + 256;
    const bf16_t* gk0 = kbase + (size_t)(c0 >> 3) * ODD_IN + (c0 & 7) * 8;
    const bf16_t* gk1 = kbase + (size_t)(c1 >> 3) * ODD_IN + (c1 & 7) * 8;
    const bf16_t* gv0 = vbase + (size_t)(c0 >> 3) * S + (c0 & 7) * 8;
    const bf16_t* gv1 = vbase + (size_t)(c1 >> 3) * S + (c1 & 7) * 8;
    for (int t = t_lo; t <= t_hi; ++t) {
      const size_t ko = (size_t)t * 64 * ODD_IN;
      const int vo = t * 64;
      const uint4 k0 = *(const uint4*)(gk0 + ko), k1 = *(const uint4*)(gk1 + ko);
      const uint4 v0 = *(const uint4*)(gv0 + vo), v1 = *(const uint4*)(gv1 + vo);
      __syncthreads();
      *(uint4*)(sK + (c0 >> 3) * KS64 + (c0 & 7) * 8) = k0;
      *(uint4*)(sK + (c1 >> 3) * KS64 + (c1 & 7) * 8) = k1;
      lds_put16(sV + (c0 >> 3) * VS + (c0 & 7) * 8, v0);
      lds_put16(sV + (c1 >> 3) * VS + (c1 & 7) * 8, v1);
      __syncthreads();
      int rr = r, hh2 = h;
      asm volatile("" : "+v"(rr), "+v"(hh2));
      const int kp0 = t * 64;
      attn_tile<2, KS64, true>(sK, sV, qf, o, mrow, lrow, r, h, [&](int qt, int sub, int i, float raw) {
        const int qp = q0 + qt * 32 + rr, kp = kp0 + sub * 32 + (i & 3) + 8 * (i >> 2) + 4 * hh2;
        const int dd = qp - kp;
        return (dd <= 128 && dd >= -128) ? raw : -INFINITY;
      }, sc);
    }
    attn64_store_out<2>(p, o, lrow, b * S + q0, head * 64, r, h);
    __syncthreads();
  }
}

DI void phase_peer_topk(const Params& p, int layer, char* smem, int tid_, int bid_) {
  float (*qs)[128] = (float (*)[128])smem;
  float (*sc)[129] = (float (*)[129])(smem + 32 * 128 * 4);
  const int tid = tid_;
  for (int tile = bid_; tile < (M / 32) * 16; tile += gridDim.x) {
    const int hp = tile & 15, tg = tile >> 4;
    const int t0 = tg * 32;
    __syncthreads();
#pragma unroll
    for (int i = 0; i < 4; ++i) {
      const int idx = tid + i * 256;
      const int rr = idx >> 5, cc = idx & 31;
      *(float4*)(&qs[rr][cc * 4]) = *(const float4*)(p.qpeer() + (size_t)(t0 + rr) * 2048 + hp * 128 + cc * 4);
    }
    __syncthreads();
    const int n = tid & 127, g = tid >> 7;
    const float* kt = p.dtmp() + ((size_t)(layer * 16 + hp) * 128) * 128 + n;
    float a[16];
#pragma unroll
    for (int t = 0; t < 16; ++t) a[t] = 0.f;
    for (int e = 0; e < 128; ++e) {
      const float kv = kt[(size_t)e * 128];
#pragma unroll
      for (int t = 0; t < 16; ++t) a[t] += qs[g * 16 + t][e] * kv;
    }
#pragma unroll
    for (int t = 0; t < 16; ++t) sc[g * 16 + t][n] = a[t];
    __syncthreads();
    if (tid < 32) {
      unsigned keys[16];
#pragma unroll
      for (int j = 0; j < 16; ++j) keys[j] = 0u;
      for (int nn = 0; nn < 128; ++nn) {
        unsigned k = (ordkey(sc[tid][nn]) & ~127u) | (unsigned)(127 - nn);
#pragma unroll
        for (int j = 0; j < 16; ++j) {
          const unsigned hi = max(keys[j], k);
          k = min(keys[j], k);
          keys[j] = hi;
        }
      }
      const size_t ob = ((size_t)(t0 + tid) * 16 + hp) * 16;
#pragma unroll
      for (int j = 0; j < 16; ++j) {
        const int id = 127 - (int)(keys[j] & 127u);
        p.si()[ob + j] = id;
        p.sv()[ob + j] = sc[tid][id];
      }
    }
  }
}

DI void phase_peer_final(const Params& p, int layer, char* smem, int tid_, int bid_) {
  const int lane = tid_ & 63, wave = tid_ >> 6;
  int* le = (int*)(smem + wave * 1024);
  float* lg = (float*)(smem + wave * 1024 + 512);
  const unsigned char* ub = (const unsigned char*)p.u_bf() + (size_t)layer * NEXP * D;
  const unsigned char* vb = (const unsigned char*)p.v_bf() + (size_t)layer * NEXP * D;
  const float* g = p.ln_g + (size_t)(layer * 2 + 1) * D;
  const float* be = p.ln_b + (size_t)(layer * 2 + 1) * D;
  const bool last = (layer == DEPTH - 1);
  float* dstx = last ? p.out : p.x2buf();
  const int lane0_ = lane;
  for (int token = bid_ * 4 + wave; token < M; token += gridDim.x * 4) {
    int lane = lane0_;
    asm volatile("" : "+v"(lane));
    const int b = token / S;
    {
      const int head = lane & 7;
      const size_t b0 = ((size_t)token * 16 + head * 2) * 16;
      float* svl = (float*)(smem + 4096 + wave * 2304);
      int* sil = (int*)(smem + 4096 + wave * 2304 + 1152);
      {
        const int qq = lane >> 3;
        const float4 tv = *(const float4*)(p.sv() + b0 + qq * 4);
        const int4 ti = *(const int4*)(p.si() + b0 + qq * 4);
        float* dv = svl + head * 33 + qq * 4;
        int* di = sil + head * 33 + qq * 4;
        dv[0] = tv.x; dv[1] = tv.y; dv[2] = tv.z; dv[3] = tv.w;
        di[0] = ti.x; di[1] = ti.y; di[2] = ti.z; di[3] = ti.w;
      }
      __builtin_amdgcn_wave_barrier();
      const float* sv0 = svl + head * 33;
      const int* si0 = sil + head * 33;
      unsigned keys[16];
#pragma unroll
      for (int j = 0; j < 16; ++j) keys[j] = 0u;
      for (int i = 0; i < 16; ++i) {
        const float a = sv0[i];
        const int jmax = 16 / (i + 1);
        for (int j = 0; j < jmax; ++j) {
          const float c = sv0[16 + j];
          unsigned k = (ordkey(a + c) & ~255u) | (unsigned)(255 - (i * 16 + j));
#pragma unroll
          for (int q = 0; q < 16; ++q) {
            const unsigned hi = max(keys[q], k);
            k = min(keys[q], k);
            keys[q] = hi;
          }
        }
      }
      float ex[16], sum = 0.f;
      float fmax_ = 0.f;
#pragma unroll
      for (int q = 0; q < 16; ++q) {
        const int flat = 255 - (int)(keys[q] & 255u);
        const float val = sv0[flat >> 4] + sv0[16 + (flat & 15)];
        if (q == 0) fmax_ = val;
        ex[q] = __expf(val - fmax_);
        sum += ex[q];
      }
      const float inv = 1.0f / sum;
      __builtin_amdgcn_wave_barrier();
      if (lane < 8) {
#pragma unroll
        for (int q = 0; q < 16; ++q) {
          const int flat = 255 - (int)(keys[q] & 255u);
          const int e = si0[flat >> 4] * 128 + si0[16 + (flat & 15)];
          le[head * 16 + q] = e;
          lg[head * 16 + q] = ex[q] * inv;
        }
      }
      __builtin_amdgcn_wave_barrier();
    }
    __syncthreads();
    float x1[16], h2[16], y[16];
    const float* mb = p.mods() + ((size_t)(layer * 2 + 1) * 2 + b) * 3072;
    float4 zv[4];
    {
      float s1 = 0.f;
#pragma unroll
      for (int q = 0; q < 4; ++q) {
        zv[q] = *(const float4*)(p.zbuf() + (size_t)token * D + lane * 16 + q * 4);
        s1 += zv[q].x + zv[q].y + zv[q].z + zv[q].w;
      }
      const float mu1 = wave_sum(s1) * (1.0f / D);
      float q1 = 0.f;
#pragma unroll
      for (int q = 0; q < 4; ++q) {
        zv[q].x -= mu1; zv[q].y -= mu1; zv[q].z -= mu1; zv[q].w -= mu1;
        q1 += zv[q].x * zv[q].x + zv[q].y * zv[q].y + zv[q].z * zv[q].z + zv[q].w * zv[q].w;
      }
      const float rstd1 = rsqrtf(wave_sum(q1) * (1.0f / D) + LN_EPS);
      const float* g1 = p.ln_g + (size_t)(layer * 2) * D;
      const float* b1 = p.ln_b + (size_t)(layer * 2) * D;
#pragma unroll
      for (int q = 0; q < 4; ++q) {
        const float4 gg = *(const float4*)(g1 + lane * 16 + q * 4);
        const float4 bb = *(const float4*)(b1 + lane * 16 + q * 4);
        zv[q].x = zv[q].x * rstd1 * gg.x + bb.x; zv[q].y = zv[q].y * rstd1 * gg.y + bb.y;
        zv[q].z = zv[q].z * rstd1 * gg.z + bb.z; zv[q].w = zv[q].w * rstd1 * gg.w + bb.w;
      }
    }
#pragma unroll
    for (int q = 0; q < 4; ++q) {
      const int e0 = lane * 16 + q * 4;
      const float4 xv = zv[q];
      const float4 sh = *(const float4*)(mb + e0);
      const float4 scl = *(const float4*)(mb + D + e0);
      const int o = q * 4;
      x1[o] = xv.x; x1[o + 1] = xv.y; x1[o + 2] = xv.z; x1[o + 3] = xv.w;
      h2[o] = xv.x * (1.f + scl.x) + sh.x; h2[o + 1] = xv.y * (1.f + scl.y) + sh.y;
      h2[o + 2] = xv.z * (1.f + scl.z) + sh.z; h2[o + 3] = xv.w * (1.f + scl.w) + sh.w;
    }
#pragma unroll
    for (int i = 0; i < 16; ++i) y[i] = 0.f;
#pragma unroll 1
    for (int hd = 0; hd < 8; ++hd) {
      u32x4 ur[16], vr[16];
#pragma unroll
      for (int k = 0; k < 16; ++k) {
        const unsigned eo = (unsigned)le[hd * 16 + k] * (unsigned)D + (unsigned)lane * 16u;
        ur[k] = *(const u32x4*)(ub + eo);
        vr[k] = *(const u32x4*)(vb + eo);
      }
      float av = 0.f;
#pragma unroll
      for (int k = 0; k < 16; ++k) {
        float d = 0.f;
#pragma unroll
        for (int w4 = 0; w4 < 4; ++w4) {
          const auto lo = __builtin_amdgcn_cvt_pk_f32_fp8((int)ur[k][w4], false);
          const auto hi = __builtin_amdgcn_cvt_pk_f32_fp8((int)ur[k][w4], true);
          d += h2[w4 * 4 + 0] * lo[0] + h2[w4 * 4 + 1] * lo[1] + h2[w4 * 4 + 2] * hi[0] + h2[w4 * 4 + 3] * hi[1];
        }
        const float tot = wave_sum(d);
        av = (lane == k) ? tot : av;
      }
      av *= (1.0f / U_SCALE);
      const float gel = 0.5f * av * (1.0f + erff(av * 0.70710678118654752f));
      const float wv = lg[hd * 16 + (lane & 15)] * gel * (1.0f / V_SCALE);
#pragma unroll
      for (int k = 0; k < 16; ++k) {
        const float w = __int_as_float(__builtin_amdgcn_readlane(__float_as_int(wv), k));
#pragma unroll
        for (int w4 = 0; w4 < 4; ++w4) {
          const auto lo = __builtin_amdgcn_cvt_pk_f32_fp8((int)vr[k][w4], false);
          const auto hi = __builtin_amdgcn_cvt_pk_f32_fp8((int)vr[k][w4], true);
          y[w4 * 4 + 0] += w * lo[0]; y[w4 * 4 + 1] += w * lo[1]; y[w4 * 4 + 2] += w * hi[0]; y[w4 * 4 + 3] += w * hi[1];
        }
      }
    }
    float z[16], s = 0.f;
#pragma unroll
    for (int q = 0; q < 4; ++q) {
      const int e0 = lane * 16 + q * 4;
      const float4 gt = *(const float4*)(mb + 2 * D + e0);
      const int o = q * 4;
      z[o] = ALPHA * x1[o] + gt.x * y[o]; z[o + 1] = ALPHA * x1[o + 1] + gt.y * y[o + 1];
      z[o + 2] = ALPHA * x1[o + 2] + gt.z * y[o + 2]; z[o + 3] = ALPHA * x1[o + 3] + gt.w * y[o + 3];
      s += z[o] + z[o + 1] + z[o + 2] + z[o + 3];
    }
    const float mu = wave_sum(s) * (1.0f / D);
    float qq = 0.f;
#pragma unroll
    for (int i = 0; i < 16; ++i) { z[i] -= mu; qq += z[i] * z[i]; }
    const float rstd = rsqrtf(wave_sum(qq) * (1.0f / D) + LN_EPS);
    const float* mbn = last ? nullptr : (p.mods() + ((size_t)((layer + 1) * 2 + 0) * 2 + b) * 3072);
#pragma unroll
    for (int q = 0; q < 4; ++q) {
      const int e0 = lane * 16 + q * 4;
      const float4 gg = *(const float4*)(g + e0);
      const float4 bb = *(const float4*)(be + e0);
      const int o = q * 4;
      float4 xo;
      xo.x = z[o] * rstd * gg.x + bb.x; xo.y = z[o + 1] * rstd * gg.y + bb.y;
      xo.z = z[o + 2] * rstd * gg.z + bb.z; xo.w = z[o + 3] * rstd * gg.w + bb.w;
      *(float4*)(dstx + (size_t)token * D + e0) = xo;
      if (!last) {
        const float4 sh = *(const float4*)(mbn + e0);
        const float4 scl = *(const float4*)(mbn + D + e0);
        *(uint2*)(p.hbuf() + (size_t)token * D + e0) =
            make_uint2(pack2(xo.x * (1.f + scl.x) + sh.x, xo.y * (1.f + scl.y) + sh.y), pack2(xo.z * (1.f + scl.z) + sh.z, xo.w * (1.f + scl.w) + sh.w));
      }
    }
    __syncthreads();
  }
}


#define XB_TMO      128
#define XB_XCNT(j)  (256  + 64 * (j))
#define XB_XSUB(j)  (1280 + 64 * (j))
#define XB_XGEN(j)  (2304 + 64 * (j))
#define XB_TOP      3328
#define XB_TOPGEN   3392
#define XCD_BAR_WORDS 3456
#define XB_SPIN_CAP (1u << 18)
#define LAS __attribute__((address_space(3)))
DI unsigned xb_ld(unsigned* p) { return __hip_atomic_load(p, __ATOMIC_RELAXED, __HIP_MEMORY_SCOPE_AGENT); }
DI unsigned xb_add(unsigned* p, unsigned v) { return __hip_atomic_fetch_add(p, v, __ATOMIC_RELAXED, __HIP_MEMORY_SCOPE_AGENT); }
DI unsigned xb_xcc_id() { return (unsigned)__builtin_amdgcn_s_getreg((3 << 11) | 20) & 0xFu; }
#define XB_SPIN(cond, bar) do { unsigned _sp = 0; while (cond) { __builtin_amdgcn_s_sleep(1); \
    if ((++_sp & 255u) == 0u) { if (xb_ld(&(bar)[XB_TMO])) break; if (_sp > XB_SPIN_CAP) { atomicAdd(&(bar)[XB_TMO], 1u); break; } } } } while (0)
struct XcdBarrier { unsigned* bar; unsigned x; volatile LAS unsigned* st; };
DI XcdBarrier xcd_barrier_post(unsigned* bar, volatile LAS unsigned* st, bool t0) {
  XcdBarrier b; b.bar = bar; b.x = xb_xcc_id(); b.st = st;
  if (t0) (void)xb_add(&bar[XB_XCNT(b.x)], 1u);
  return b;
}
DI void xcd_barrier_complete(unsigned* bar, unsigned x, unsigned& nloc, unsigned& nx) {
  const unsigned G = gridDim.x;
  unsigned sum, cnt, mine, sp = 0u;
  for (;;) {
    sum = 0u; cnt = 0u; mine = 0u;
#pragma unroll
    for (unsigned j = 0; j < 16; ++j) { const unsigned c = xb_ld(&bar[XB_XCNT(j)]); sum += c; cnt += (c > 0u) ? 1u : 0u; mine = (j == x) ? c : mine; }
    if (sum == G) break;
    __builtin_amdgcn_s_sleep(1);
    if ((++sp & 255u) == 0u) { if (xb_ld(&bar[XB_TMO])) break; if (sp > XB_SPIN_CAP) { atomicAdd(&bar[XB_TMO], 1u); break; } }
  }
  nloc = mine > 0u ? mine : 1u; nx = cnt > 0u ? cnt : 1u;
}
DI void xcd_barrier(const XcdBarrier& b, bool t0) {
  asm volatile("s_waitcnt vmcnt(0)" ::: "memory");
  __syncthreads();
  if (t0) {
    unsigned* bar = b.bar;
    __builtin_amdgcn_s_waitcnt(0);
    unsigned nloc = b.st[0], nx = b.st[1];
    if (nloc == 0u) { xcd_barrier_complete(bar, b.x, nloc, nx); b.st[0] = nloc; b.st[1] = nx; }
    const unsigned old = xb_add(&bar[XB_XSUB(b.x)], 1u);
    const unsigned gen = old / nloc;
    if (old + 1u == (gen + 1u) * nloc) {
      __builtin_amdgcn_fence(__ATOMIC_RELEASE, "agent");
      asm volatile("s_waitcnt vmcnt(0)" ::: "memory");
      const unsigned og = xb_add(&bar[XB_TOP], 1u);
      const unsigned tg = og / nx;
      if (og + 1u == (tg + 1u) * nx) xb_add(&bar[XB_TOPGEN], 1u);
      else XB_SPIN(xb_ld(&bar[XB_TOPGEN]) == tg, bar);
      __builtin_amdgcn_fence(__ATOMIC_ACQUIRE, "agent");
      xb_add(&bar[XB_XGEN(b.x)], 1u);
      asm volatile("s_waitcnt vmcnt(0)" ::: "memory");
    } else {
      XB_SPIN(xb_ld(&bar[XB_XGEN(b.x)]) == gen, bar);
      __builtin_amdgcn_fence(__ATOMIC_ACQUIRE, "agent");
      asm volatile("s_waitcnt vmcnt(0)" ::: "memory");
    }
  }
  __syncthreads();
}

typedef const __attribute__((address_space(4))) Params* KParamsPtr;
__global__ void __launch_bounds__(NTHR, 2) mega(Params p_arg) {
  extern __shared__ __attribute__((aligned(16))) char smem[];
  cg::grid_group grid = cg::this_grid();
  const int ph_lo = p_arg.ph_lo, ph_hi = p_arg.ph_hi;
  __shared__ uint4 xb_words;
  if (threadIdx.x == 0) xb_words = make_uint4(0u, 0u, 0u, 0u);
  __syncthreads();
  const XcdBarrier xb = xcd_barrier_post((unsigned*)(p_arg.ws + OFF_bar), (volatile LAS unsigned*)&xb_words, threadIdx.x == 0);
  const int wave_s = __builtin_amdgcn_readfirstlane(threadIdx.x >> 6);
  bool dup_done = false;
  for (int ph = ph_lo; ph < ph_hi; ++ph) {
#if FUSED_TOPK
    if (ph >= 2 && ((((ph - 2) & 7) == 6 && !TOPK_SEPARATE) || ((ph - 2) & 7) == 2)) continue;
#endif
    int ws_ = wave_s, zero_ = 0, bid_ = blockIdx.x;
    asm volatile("" : "+s"(ws_), "+s"(zero_), "+s"(bid_));
    const int tid_ = ws_ * 64 + (int)__builtin_amdgcn_mbcnt_hi(~0u, __builtin_amdgcn_mbcnt_lo(~0u, (unsigned)zero_));
#if defined(__HIP_DEVICE_COMPILE__)
    KParamsPtr kp = (KParamsPtr)__builtin_amdgcn_kernarg_segment_ptr();
    asm volatile("" : "+s"(kp));
    const Params p = *kp;
#else
    const Params p = p_arg;
#endif
    if (ph == 0) {
      phase_prep(p, smem, tid_, bid_);
    } else if (ph == 1) {
      phase_ln_mod(p, p.x, false, nullptr, nullptr, nullptr, p.mods(), p.hbuf(), tid_, bid_);
    } else {
      const int layer = (ph - 2) >> 3, sub = (ph - 2) & 7;
      const bool even = (layer & 1) == 0;
      const int li = layer >> 1;
      const float* xres = (layer == 0) ? p.x : p.x2buf();
      switch (sub) {
        case 0:
          if (even) phase_gemm<EPI_EVEN>(p, p.hbuf(), p.w_in_even_t() + (size_t)li * D * EVEN_IN, EVEN_IN, layer, nullptr, smem, tid_, bid_);
          else phase_gemm<EPI_ODD>(p, p.hbuf(), p.w_in_odd_t() + (size_t)li * D * ODD_IN, ODD_IN, layer, nullptr, smem, tid_, bid_);
          break;
        case 1:
#if NAIVE_ATTN
          if (even) phase_attn_even_naive(p, li, tid_, bid_);
          else phase_attn_odd_naive(p, li, tid_, bid_);
#else
          if (even) { phase_na_mfma(p, li, smem, tid_, bid_); phase_diff_mfma(p, li, smem, tid_, bid_); }
          else phase_swa_mfma(p, li, smem, tid_, bid_);
#endif
          break;
        case 2:
#if NAIVE_ATTN
          if (even) phase_diff_combine(p, li, tid_, bid_);
#endif
          break;
        case 3:
          phase_gemm<EPI_OUT>(p, p.obuf(), (even ? p.w_out_even_t() : p.w_out_odd_t()) + (size_t)li * D * D, D, layer, xres, smem, tid_, bid_);
          break;
        case 4:
          phase_ln_mod(p, p.zbuf(), true, p.ln_g + (size_t)(layer * 2) * D, p.ln_b + (size_t)(layer * 2) * D, nullptr  ,
                       p.mods() + (size_t)(layer * 2 + 1) * 2 * 3072, p.hbuf(), tid_, bid_);
          break;
        case 5:
          phase_gemm<EPI_Q>(p, p.hbuf(), p.wq_t() + (size_t)layer * D * 2048, 2048, layer, nullptr, smem, tid_, bid_);
          break;
        case 6:
#if !FUSED_TOPK
          phase_peer_topk(p, layer, smem, tid_, bid_);
#elif TOPK_SEPARATE
          phase_topk_mfma(p, layer, smem, tid_, bid_);
#endif
          break;
        case 7:
          phase_peer_final(p, layer, smem, tid_, bid_);
          break;
      }
    }
#if DUP_MASK
    if (ph >= 2 && ((DUP_MASK >> ((ph - 2) & 7)) & 1) && !dup_done) { dup_done = true; --ph; } else dup_done = false;
#endif
    if (ph + 1 < ph_hi) {
      asm volatile("s_waitcnt vmcnt(0)" ::: "memory");
      if (ph_hi > NPHASE) grid.sync();
      else xcd_barrier(xb, tid_ == 0);
    }
  }
}

extern "C" void kernel_launch(void* const* d_in, const int* in_sizes, int n_in, void* d_out, int out_size, void* d_ws, size_t ws_size,
                              hipStream_t stream) {
  static int grid_blocks = 0;
  if (!grid_blocks) {
    int dev = 0, cus = 0, per_cu = 0;
    hipGetDevice(&dev);
    hipDeviceGetAttribute(&cus, hipDeviceAttributeMultiprocessorCount, dev);
    hipOccupancyMaxActiveBlocksPerMultiprocessor(&per_cu, mega, NTHR, LDS_BYTES);
    if (per_cu < 1) per_cu = 1;
    if (per_cu > 2) per_cu = 2;
    grid_blocks = cus * per_cu;
    fprintf(stderr, "kernel_launch: cus %d per_cu %d grid %d ws %zu\n", cus, per_cu, grid_blocks, ws_size);
  }
  Params p{};
  const float** ins = (const float**)&p.x;
  for (int i = 0; i < 21; ++i) ins[i] = (const float*)d_in[i];
  p.out = (float*)d_out;
  p.ws = (char*)d_ws;
  const size_t off = WS_TOTAL;
  if (off > ws_size) { fprintf(stderr, "kernel_launch: workspace too small: need %zu have %zu\n", off, ws_size); return; }
#if ONE_LAUNCH
  (void)hipMemsetAsync((char*)d_ws + OFF_bar, 0, (size_t)XCD_BAR_WORDS_C * 4, stream);
  p.ph_lo = 0; p.ph_hi = NPHASE;
  void* args[] = {&p};
  hipError_t e = hipLaunchCooperativeKernel((void*)mega, dim3(grid_blocks), dim3(NTHR), args, LDS_BYTES, stream);
  if (e != hipSuccess) fprintf(stderr, "cooperative launch failed: %s (grid %d)\n", hipGetErrorString(e), grid_blocks);
#else
  for (int ph = 0; ph < NPHASE; ++ph) {
    if (((ph - 2) & 7) == 2 && ph >= 2 && (((ph - 2) >> 3) & 1)) continue;
    p.ph_lo = ph; p.ph_hi = ph + 1;
    hipLaunchKernelGGL(mega, dim3(grid_blocks), dim3(NTHR), LDS_BYTES, stream, p);
  }
#endif
}
```

```cpp
#include <hip/hip_runtime.h>
#include <hip/hip_cooperative_groups.h>
#include <cstdio>
namespace cg = cooperative_groups;

#ifndef DUP_MASK
#define DUP_MASK 0
#endif
#ifndef FUSED_TOPK
#define FUSED_TOPK 1
#ifndef TOPK_SEPARATE
#define TOPK_SEPARATE 0
#endif
#endif
#ifndef NAIVE_ATTN
#define NAIVE_ATTN 0
#endif
#ifndef ONE_LAUNCH
#define ONE_LAUNCH 1
#endif

#define DI __device__ __forceinline__
typedef unsigned short bf16_t;
using bf16x8 = __attribute__((ext_vector_type(8))) short;
using f32x16 = __attribute__((ext_vector_type(16))) float;

constexpr int NB = 2, S = 8192, D = 1024, M = NB * S, DEPTH = 4;
constexpr int EVEN_IN = 3072, ODD_IN = 1536, NEXP = 16384;
constexpr float ALPHA = 1.681792830507429f;
constexpr float LN_EPS = 1e-5f;
constexpr float U_SCALE = 64.0f, V_SCALE = 8.0f;
using u32x4 = __attribute__((ext_vector_type(4))) unsigned;
constexpr int NTHR = 256;
constexpr int LDS_BYTES = 74752;
constexpr int NPHASE = 2 + 8 * DEPTH;

constexpr int XCD_BAR_WORDS_C = 3456;
constexpr size_t al256(size_t x) { return (x + 255) & ~(size_t)255; }
constexpr size_t OFF_mods = 0;
constexpr size_t OFF_ropec = OFF_mods + al256((size_t)DEPTH * 2 * 2 * 3072 * 4);
constexpr size_t OFF_ropes = OFF_ropec + al256((size_t)S * 32 * 4);
constexpr size_t OFF_lam = OFF_ropes + al256((size_t)S * 32 * 4);
constexpr size_t OFF_subkT = OFF_lam + al256(256);
constexpr size_t OFF_w_in_even_t = OFF_subkT + al256((size_t)DEPTH * 16 * 128 * 128 * 4);
constexpr size_t OFF_w_out_even_t = OFF_w_in_even_t + al256((size_t)2 * D * EVEN_IN * 2);
constexpr size_t OFF_w_in_odd_t = OFF_w_out_even_t + al256((size_t)2 * D * D * 2);
constexpr size_t OFF_w_out_odd_t = OFF_w_in_odd_t + al256((size_t)2 * D * ODD_IN * 2);
constexpr size_t OFF_wq_t = OFF_w_out_odd_t + al256((size_t)2 * D * D * 2);
constexpr size_t OFF_u_bf = OFF_wq_t + al256((size_t)DEPTH * D * 2048 * 2);
constexpr size_t OFF_v_bf = OFF_u_bf + al256((size_t)DEPTH * NEXP * D * 2);
constexpr size_t OFF_xcur = OFF_v_bf + al256((size_t)DEPTH * NEXP * D * 2);
constexpr size_t OFF_zbuf = OFF_xcur + al256(256);
constexpr size_t OFF_qpeer = OFF_zbuf + al256((size_t)M * D * 4);
constexpr size_t OFF_sv = OFF_qpeer + al256(256);
constexpr size_t OFF_dtmp = OFF_sv + al256((size_t)M * 256 * 4);
constexpr size_t OFF_si = OFF_dtmp + al256(256);
constexpr size_t OFF_hbuf = OFF_si + al256((size_t)M * 256 * 4);
constexpr size_t OFF_proj = OFF_hbuf + al256((size_t)M * D * 2);
constexpr size_t OFF_obuf = OFF_proj + al256((size_t)M * EVEN_IN * 2);
constexpr size_t OFF_vT = OFF_obuf + al256((size_t)M * D * 2);
constexpr size_t OFF_x2buf = OFF_vT + al256((size_t)M * D * 2);
constexpr size_t OFF_bar = OFF_x2buf + al256((size_t)M * D * 4);
constexpr size_t WS_TOTAL = OFF_bar + al256((size_t)XCD_BAR_WORDS_C * 4);

struct Params {
  const float *x, *c, *w_ada, *b_ada, *ln_g, *ln_b, *w_in_even, *rpb, *lq1, *lk1, *lq2, *lk2, *sub_g, *w_out_even,
      *w_in_odd, *sink, *w_out_odd, *wq, *subk, *pu, *pv;
  float* out;
  char* ws;
  int ph_lo, ph_hi;
  DI float* mods() const { return (float*)(ws + OFF_mods); }
  DI float* ropec() const { return (float*)(ws + OFF_ropec); }
  DI float* ropes() const { return (float*)(ws + OFF_ropes); }
  DI float* lam() const { return (float*)(ws + OFF_lam); }
  DI float* subkT() const { return (float*)(ws + OFF_subkT); }
  DI bf16_t* w_in_even_t() const { return (bf16_t*)(ws + OFF_w_in_even_t); }
  DI bf16_t* w_out_even_t() const { return (bf16_t*)(ws + OFF_w_out_even_t); }
  DI bf16_t* w_in_odd_t() const { return (bf16_t*)(ws + OFF_w_in_odd_t); }
  DI bf16_t* w_out_odd_t() const { return (bf16_t*)(ws + OFF_w_out_odd_t); }
  DI bf16_t* wq_t() const { return (bf16_t*)(ws + OFF_wq_t); }
  DI bf16_t* u_bf() const { return (bf16_t*)(ws + OFF_u_bf); }
  DI bf16_t* v_bf() const { return (bf16_t*)(ws + OFF_v_bf); }
  DI float* xcur() const { return (float*)(ws + OFF_xcur); }
  DI float* zbuf() const { return (float*)(ws + OFF_zbuf); }
  DI float* qpeer() const { return (float*)(ws + OFF_qpeer); }
  DI float* sv() const { return (float*)(ws + OFF_sv); }
  DI float* dtmp() const { return (float*)(ws + OFF_dtmp); }
  DI int* si() const { return (int*)(ws + OFF_si); }
  DI bf16_t* hbuf() const { return (bf16_t*)(ws + OFF_hbuf); }
  DI bf16_t* proj() const { return (bf16_t*)(ws + OFF_proj); }
  DI bf16_t* obuf() const { return (bf16_t*)(ws + OFF_obuf); }
  DI bf16_t* vT() const { return (bf16_t*)(ws + OFF_vT); }
  DI float* x2buf() const { return (float*)(ws + OFF_x2buf); }
};

DI float bf2f(bf16_t v) { return __uint_as_float(((unsigned)v) << 16); }
DI bf16_t f2bf(float f) { unsigned u = __float_as_uint(f); u += 0x7fffu + ((u >> 16) & 1u); return (bf16_t)(u >> 16); }
DI float bflo(unsigned u) { return __uint_as_float(u << 16); }
DI float bfhi(unsigned u) { return __uint_as_float(u & 0xffff0000u); }
DI unsigned pack2(float a, float b) { return (unsigned)f2bf(a) | ((unsigned)f2bf(b) << 16); }
typedef __bf16 hwbf16x2 __attribute__((ext_vector_type(2)));
typedef float hwf32x2 __attribute__((ext_vector_type(2)));
DI unsigned pack2_hw(float a, float b) {
  const hwf32x2 v = {a, b};
  return __builtin_bit_cast(unsigned, __builtin_convertvector(v, hwbf16x2));
}
DI unsigned ordkey(float f) { unsigned u = __float_as_uint(f); return u ^ ((unsigned)((int)u >> 31) | 0x80000000u); }
DI float unordkey(unsigned k) { unsigned u = (k & 0x80000000u) ? (k ^ 0x80000000u) : ~k; return __uint_as_float(u); }
template <int CTRL> DI float dpp_f(float v) { return __int_as_float(__builtin_amdgcn_mov_dpp(__float_as_int(v), CTRL, 0xf, 0xf, true)); }
DI float wave_sum(float v) {
  v += dpp_f<0xB1>(v);
  v += dpp_f<0x4E>(v);
  v += dpp_f<0x141>(v);
  v += dpp_f<0x140>(v);
  const float a = __int_as_float(__builtin_amdgcn_readlane(__float_as_int(v), 0)), b = __int_as_float(__builtin_amdgcn_readlane(__float_as_int(v), 16));
  const float c = __int_as_float(__builtin_amdgcn_readlane(__float_as_int(v), 32)), d = __int_as_float(__builtin_amdgcn_readlane(__float_as_int(v), 48));
  return (a + b) + (c + d);
}
DI float xhalf_max(float x) {
  auto r = __builtin_amdgcn_permlane32_swap(__float_as_uint(x), __float_as_uint(x), false, false);
  return fmaxf(__uint_as_float(r[0]), __uint_as_float(r[1]));
}
DI float xhalf_sum(float x) {
  auto r = __builtin_amdgcn_permlane32_swap(__float_as_uint(x), __float_as_uint(x), false, false);
  return __uint_as_float(r[0]) + __uint_as_float(r[1]);
}

template <typename TO> DI TO cvt_out(float v);
template <> DI float cvt_out<float>(float v) { return v; }
template <> DI bf16_t cvt_out<bf16_t>(float v) { return f2bf(v); }

template <typename TO>
DI void transpose_convert(const float* __restrict__ src, TO* __restrict__ dst, int K, int N, char* smem, int tid_, int bid_) {
  float (*tile)[65] = (float (*)[65])smem;
  const int tid = tid_;
  const int tn_cnt = N / 64, ntile = (K / 64) * tn_cnt;
  for (int t = bid_; t < ntile; t += gridDim.x) {
    const int tk = t / tn_cnt, tn = t % tn_cnt;
#pragma unroll 4
    for (int i = 0; i < 16; ++i) {
      int idx = tid + i * 256, kk = idx >> 6, nn = idx & 63;
      tile[kk][nn] = src[(size_t)(tk * 64 + kk) * N + tn * 64 + nn];
    }
    __syncthreads();
#pragma unroll 4
    for (int i = 0; i < 16; ++i) {
      int idx = tid + i * 256, nn = idx >> 6, kk = idx & 63;
      dst[(size_t)(tn * 64 + nn) * K + tk * 64 + kk] = cvt_out<TO>(tile[kk][nn]);
    }
    __syncthreads();
  }
}

DI void phase_prep(const Params& p, char* smem, int tid_, int bid_) {
  const int tid = tid_;
  {
    float* red = (float*)smem;
    for (int task = bid_; task < 8 * 48; task += gridDim.x) {
      const int ls = task / 48, cb = task % 48;
      const int col = tid & 63, kg = tid >> 6;
      float a0 = 0.f, a1 = 0.f;
      const float* w = p.w_ada + ((size_t)ls * D + kg * 256) * 3072 + cb * 64 + col;
      for (int k = 0; k < 256; ++k) {
        float c0 = p.c[kg * 256 + k], c1 = p.c[D + kg * 256 + k];
        c0 = c0 / (1.f + __expf(-c0));
        c1 = c1 / (1.f + __expf(-c1));
        float wv = w[(size_t)k * 3072];
        a0 += c0 * wv;
        a1 += c1 * wv;
      }
      red[(kg * 64 + col) * 2 + 0] = a0;
      red[(kg * 64 + col) * 2 + 1] = a1;
      __syncthreads();
      if (tid < 128) {
        const int cc = tid & 63, b = tid >> 6;
        float s = red[(0 * 64 + cc) * 2 + b] + red[(1 * 64 + cc) * 2 + b] + red[(2 * 64 + cc) * 2 + b] + red[(3 * 64 + cc) * 2 + b];
        const int e = cb * 64 + cc;
        p.mods()[((size_t)ls * 2 + b) * 3072 + e] = s + p.b_ada[(size_t)ls * 3072 + e];
      }
      __syncthreads();
    }
  }
  for (int idx = bid_ * NTHR + tid; idx < S * 32; idx += gridDim.x * NTHR) {
    const int pos = idx >> 5, j = idx & 31;
    const float inv = 1.0f / powf(10000.0f, (float)(2 * j) / 64.0f);
    const float ang = (float)pos * inv;
    p.ropec()[idx] = cosf(ang);
    p.ropes()[idx] = sinf(ang);
  }
  if (bid_ == 0 && tid < 2) {
    const int i = tid;
    float s1 = 0.f, s2 = 0.f;
    for (int d = 0; d < 64; ++d) {
      s1 += p.lq1[i * 64 + d] * p.lk1[i * 64 + d];
      s2 += p.lq2[i * 64 + d] * p.lk2[i * 64 + d];
    }
    const float li = 0.8f - 0.6f * expf(-0.3f * (float)(2 * i));
    p.lam()[i] = expf(s1) - expf(s2) + li;
    p.lam()[2 + i] = li;
  }
  for (int i = 0; i < 2; ++i) {
    transpose_convert<bf16_t>(p.w_in_even + (size_t)i * D * EVEN_IN, p.w_in_even_t() + (size_t)i * D * EVEN_IN, D, EVEN_IN, smem, tid_, bid_);
    transpose_convert<bf16_t>(p.w_out_even + (size_t)i * D * D, p.w_out_even_t() + (size_t)i * D * D, D, D, smem, tid_, bid_);
    transpose_convert<bf16_t>(p.w_in_odd + (size_t)i * D * ODD_IN, p.w_in_odd_t() + (size_t)i * D * ODD_IN, D, ODD_IN, smem, tid_, bid_);
    transpose_convert<bf16_t>(p.w_out_odd + (size_t)i * D * D, p.w_out_odd_t() + (size_t)i * D * D, D, D, smem, tid_, bid_);
  }
  for (int l = 0; l < DEPTH; ++l) transpose_convert<bf16_t>(p.wq + (size_t)l * D * 2048, p.wq_t() + (size_t)l * D * 2048, D, 2048, smem, tid_, bid_);
#if !FUSED_TOPK
  for (int q = 0; q < DEPTH * 16; ++q) transpose_convert<float>(p.subk + (size_t)q * 128 * 128, p.dtmp() + (size_t)q * 128 * 128, 128, 128, smem, tid_, bid_);
#endif
  for (int i = bid_ * NTHR + tid; i < DEPTH * 16 * 128 * 128 / 4; i += gridDim.x * NTHR) {
    const float4 a = ((const float4*)p.subk)[i];
    ((uint2*)p.subkT())[i] = make_uint2(pack2(a.x, a.y), pack2(a.z, a.w));
    const float lx = a.x - bf2f(f2bf(a.x)), ly = a.y - bf2f(f2bf(a.y)), lz = a.z - bf2f(f2bf(a.z)), lw = a.w - bf2f(f2bf(a.w));
    ((uint2*)p.subkT())[(size_t)(DEPTH * 16 * 128 * 128 / 4) + i] = make_uint2(pack2(lx, ly), pack2(lz, lw));
  }
  {
    uint4* z4 = (uint4*)(p.ws + OFF_xcur);
    const size_t n16 = (OFF_bar - OFF_xcur) / 16;
    for (size_t i = (size_t)bid_ * NTHR + tid; i < n16; i += (size_t)gridDim.x * NTHR) z4[i] = make_uint4(0u, 0u, 0u, 0u);
  }
  {
    const size_t n4 = (size_t)DEPTH * NEXP * D / 4;
    for (size_t i = (size_t)bid_ * NTHR + tid; i < n4; i += (size_t)gridDim.x * NTHR) {
      const float4 a = ((const float4*)p.pu)[i];
      const float4 b = ((const float4*)p.pv)[i];
      int ua = __builtin_amdgcn_cvt_pk_fp8_f32(a.x * U_SCALE, a.y * U_SCALE, 0, false);
      ua = __builtin_amdgcn_cvt_pk_fp8_f32(a.z * U_SCALE, a.w * U_SCALE, ua, true);
      int vb_ = __builtin_amdgcn_cvt_pk_fp8_f32(b.x * V_SCALE, b.y * V_SCALE, 0, false);
      vb_ = __builtin_amdgcn_cvt_pk_fp8_f32(b.z * V_SCALE, b.w * V_SCALE, vb_, true);
      ((int*)p.u_bf())[i] = ua;
      ((int*)p.v_bf())[i] = vb_;
    }
  }
}

DI void phase_ln_mod(const Params& p, const float* __restrict__ src, bool do_ln, const float* __restrict__ g, const float* __restrict__ bb,
                     float* __restrict__ dstx, const float* __restrict__ modbase  , bf16_t* __restrict__ dsth, int tid_, int bid_) {
  const int lane = tid_ & 63, wave = tid_ >> 6;
  const int rstride = gridDim.x * 4;
  float4 vn[4];
  {
    const int row0 = min(bid_ * 4 + wave, M - 1);
#pragma unroll
    for (int j = 0; j < 4; ++j) vn[j] = *(const float4*)(src + (size_t)row0 * D + j * 256 + lane * 4);
  }
  for (int row = bid_ * 4 + wave; row < M; row += rstride) {
    const int b = row / S;
    float4 v[4];
#pragma unroll
    for (int j = 0; j < 4; ++j) v[j] = vn[j];
    {
      const int nrow = min(row + rstride, M - 1);
#pragma unroll
      for (int j = 0; j < 4; ++j) vn[j] = *(const float4*)(src + (size_t)nrow * D + j * 256 + lane * 4);
    }
    if (do_ln) {
      float s = 0.f;
#pragma unroll
      for (int j = 0; j < 4; ++j) s += v[j].x + v[j].y + v[j].z + v[j].w;
      const float mu = wave_sum(s) * (1.0f / D);
      float q = 0.f;
#pragma unroll
      for (int j = 0; j < 4; ++j) {
        v[j].x -= mu; v[j].y -= mu; v[j].z -= mu; v[j].w -= mu;
        q += v[j].x * v[j].x + v[j].y * v[j].y + v[j].z * v[j].z + v[j].w * v[j].w;
      }
      const float rstd = rsqrtf(wave_sum(q) * (1.0f / D) + LN_EPS);
#pragma unroll
      for (int j = 0; j < 4; ++j) {
        const float4 gg = *(const float4*)(g + j * 256 + lane * 4);
        const float4 be = *(const float4*)(bb + j * 256 + lane * 4);
        v[j].x = v[j].x * rstd * gg.x + be.x; v[j].y = v[j].y * rstd * gg.y + be.y;
        v[j].z = v[j].z * rstd * gg.z + be.z; v[j].w = v[j].w * rstd * gg.w + be.w;
        if (dstx) *(float4*)(dstx + (size_t)row * D + j * 256 + lane * 4) = v[j];
      }
    }
    const float* mb = modbase + (size_t)b * 3072;
#pragma unroll
    for (int j = 0; j < 4; ++j) {
      const float4 sh = *(const float4*)(mb + j * 256 + lane * 4);
      const float4 sc = *(const float4*)(mb + D + j * 256 + lane * 4);
      float h0 = v[j].x * (1.f + sc.x) + sh.x, h1 = v[j].y * (1.f + sc.y) + sh.y;
      float h2 = v[j].z * (1.f + sc.z) + sh.z, h3 = v[j].w * (1.f + sc.w) + sh.w;
      *(uint2*)(dsth + (size_t)row * D + j * 256 + lane * 4) = make_uint2(pack2_hw(h0, h1), pack2_hw(h2, h3));
    }
  }
}


DI void topk_from_sQ(const Params& p, int layer, int tn, int m0, char* smem, int tid, int wm, int wn, int r, int h) {
  constexpr int QS = 136;
  const bf16_t* sQh = (const bf16_t*)smem;
  const bf16_t* sQl = sQh + 128 * QS;
  f32x16 acc[2][2];
  const bf16_t* kh = (const bf16_t*)p.subkT() + (size_t)(layer * 16 + tn) * 128 * 128;
  const bf16_t* kl = kh + (size_t)DEPTH * 16 * 128 * 128;
#pragma unroll
  for (int a = 0; a < 2; ++a)
#pragma unroll
    for (int b = 0; b < 2; ++b)
#pragma unroll
      for (int i = 0; i < 16; ++i) acc[a][b][i] = 0.f;
#pragma unroll 2
  for (int ks = 0; ks < 8; ++ks) {
    bf16x8 khf[2], klf[2], qhf[2], qlf[2];
#pragma unroll
    for (int i = 0; i < 2; ++i) {
      const size_t ko = (size_t)(wm * 64 + i * 32 + r) * 128 + ks * 16 + h * 8;
      khf[i] = *(const bf16x8*)(kh + ko);
      klf[i] = *(const bf16x8*)(kl + ko);
      const int qo = (wn * 64 + i * 32 + r) * QS + ks * 16 + h * 8;
      qhf[i] = *(const bf16x8*)(sQh + qo);
      qlf[i] = *(const bf16x8*)(sQl + qo);
    }
#pragma unroll
    for (int a = 0; a < 2; ++a)
#pragma unroll
      for (int b = 0; b < 2; ++b) {
        acc[a][b] = __builtin_amdgcn_mfma_f32_32x32x16_bf16(klf[a], qhf[b], acc[a][b], 0, 0, 0);
        acc[a][b] = __builtin_amdgcn_mfma_f32_32x32x16_bf16(khf[a], qlf[b], acc[a][b], 0, 0, 0);
        acc[a][b] = __builtin_amdgcn_mfma_f32_32x32x16_bf16(khf[a], qhf[b], acc[a][b], 0, 0, 0);
      }
  }
  unsigned* sM = (unsigned*)smem;
  __syncthreads();
#pragma unroll
  for (int b = 0; b < 2; ++b) {
    unsigned v[32];
#pragma unroll
    for (int a = 0; a < 2; ++a)
#pragma unroll
      for (int i = 0; i < 16; ++i) {
        const int n = wm * 64 + a * 32 + (i & 3) + 8 * (i >> 2) + 4 * h;
        v[a * 16 + i] = (ordkey(acc[a][b][i]) & ~127u) | (unsigned)(127 - n);
      }
#pragma unroll
    for (int k = 2; k <= 32; k <<= 1)
#pragma unroll
      for (int j = k >> 1; j > 0; j >>= 1)
#pragma unroll
        for (int i = 0; i < 32; ++i) {
          const int l = i ^ j;
          if (l > i) {
            const unsigned x = v[i], y = v[l];
            const bool desc = ((i & k) == 0);
            v[i] = desc ? max(x, y) : min(x, y);
            v[l] = desc ? min(x, y) : max(x, y);
          }
        }
    unsigned* dst = sM + (wn * 64 + b * 32 + r) * 68 + (wm * 2 + h) * 16;
#pragma unroll
    for (int q4 = 0; q4 < 4; ++q4) *(uint4*)(dst + q4 * 4) = make_uint4(v[q4 * 4], v[q4 * 4 + 1], v[q4 * 4 + 2], v[q4 * 4 + 3]);
    __builtin_amdgcn_sched_barrier(0);
  }
  __syncthreads();
  if (tid < 128) {
    const unsigned* L = sM + tid * 68;
    int p0 = 0, p1 = 16, p2 = 32, p3 = 48;
    unsigned h0 = L[0], h1 = L[16], h2 = L[32], h3 = L[48];
    const size_t ob = ((size_t)(m0 + tid) * 16 + tn) * 16;
    float ov[16];
    int oi[16];
#pragma unroll
    for (int j = 0; j < 16; ++j) {
      const unsigned mx = max(max(h0, h1), max(h2, h3));
      ov[j] = unordkey(mx & ~127u);
      oi[j] = 127 - (int)(mx & 127u);
      const bool s0 = (mx == h0), s1 = (mx == h1), s2 = (mx == h2), s3 = (mx == h3);
      p0 += s0; p1 += s1; p2 += s2; p3 += s3;
      const int pa = s0 ? p0 : (s1 ? p1 : (s2 ? p2 : p3));
      const int lim = s0 ? 16 : (s1 ? 32 : (s2 ? 48 : 64));
      const unsigned nv = L[min(pa, 63)];
      const unsigned nh = (pa < lim) ? nv : 0u;
      h0 = s0 ? nh : h0; h1 = s1 ? nh : h1; h2 = s2 ? nh : h2; h3 = s3 ? nh : h3;
    }
#pragma unroll
    for (int q4 = 0; q4 < 4; ++q4) {
      *(float4*)(p.sv() + ob + q4 * 4) = make_float4(ov[q4 * 4], ov[q4 * 4 + 1], ov[q4 * 4 + 2], ov[q4 * 4 + 3]);
      *(int4*)(p.si() + ob + q4 * 4) = make_int4(oi[q4 * 4], oi[q4 * 4 + 1], oi[q4 * 4 + 2], oi[q4 * 4 + 3]);
    }
  }

}


DI void phase_topk_mfma(const Params& p, int layer, char* smem, int tid_, int bid_) {
  constexpr int QS = 136;
  bf16_t* sQ = (bf16_t*)smem;
  const bf16_t* qb = (const bf16_t*)p.qpeer();
  const int tid = tid_, lane = tid & 63, wave = tid >> 6;
  const int wm = wave >> 1, wn = wave & 1, r = lane & 31, h = lane >> 5;
  for (int t = bid_; t < (M / 128) * 16; t += gridDim.x) {
    const int tm = t >> 4, tn = t & 15, m0 = tm * 128;
    __syncthreads();
#pragma unroll
    for (int i = 0; i < 8; ++i) {
      const int c = tid + i * 256;
      *(uint4*)(sQ + (c >> 4) * QS + (c & 15) * 8) = *(const uint4*)(qb + (size_t)(m0 + (c >> 4)) * 2048 + tn * 128 + (c & 15) * 8);
    }
    __syncthreads();
    topk_from_sQ(p, layer, tn, m0, smem, tid, wm, wn, r, h);
  }
}

enum { EPI_EVEN = 0, EPI_ODD = 1, EPI_OUT = 2, EPI_Q = 3 };
constexpr int LDA = 72;

template <int EPI>
DI void phase_gemm(const Params& p, const bf16_t* __restrict__ A, const bf16_t* __restrict__ Bt, int N, int layer, const float* __restrict__ xres,
                   char* smem, int tid_, int bid_) {
  constexpr int K = D;
  bf16_t* sA = (bf16_t*)smem;
  bf16_t* sB = sA + 128 * LDA;
  const int tid = tid_, lane = tid & 63, wave = tid >> 6;
  const int wm = wave >> 1, wn = wave & 1, r = lane & 31, h = lane >> 5;
  const int tn_cnt = N / 128, ntile = (M / 128) * tn_cnt;
  const int per_x = ntile >> 3;
  for (int l = bid_ >> 3; l < per_x; l += (int)(gridDim.x >> 3)) {
    const int t = (bid_ & 7) * per_x + l;
    const int tm = t / tn_cnt, tn = t % tn_cnt;
    const int m0 = tm * 128, n0 = tn * 128;
    f32x16 acc[2][2];
#pragma unroll
    for (int a = 0; a < 2; ++a)
#pragma unroll
      for (int b = 0; b < 2; ++b)
#pragma unroll
        for (int i = 0; i < 16; ++i) acc[a][b][i] = 0.f;
    const int c0 = tid, c1 = tid + 256, c2 = tid + 512, c3 = tid + 768;
    const bf16_t* ga0 = A + (size_t)(m0 + (c0 >> 3)) * K + (c0 & 7) * 8;
    const bf16_t* ga1 = A + (size_t)(m0 + (c1 >> 3)) * K + (c1 & 7) * 8;
    const bf16_t* ga2 = A + (size_t)(m0 + (c2 >> 3)) * K + (c2 & 7) * 8;
    const bf16_t* ga3 = A + (size_t)(m0 + (c3 >> 3)) * K + (c3 & 7) * 8;
    const bf16_t* gb0 = Bt + (size_t)(n0 + (c0 >> 3)) * K + (c0 & 7) * 8;
    const bf16_t* gb1 = Bt + (size_t)(n0 + (c1 >> 3)) * K + (c1 & 7) * 8;
    const bf16_t* gb2 = Bt + (size_t)(n0 + (c2 >> 3)) * K + (c2 & 7) * 8;
    const bf16_t* gb3 = Bt + (size_t)(n0 + (c3 >> 3)) * K + (c3 & 7) * 8;
    uint4 ra0 = *(const uint4*)ga0, ra1 = *(const uint4*)ga1, ra2 = *(const uint4*)ga2, ra3 = *(const uint4*)ga3;
    uint4 rb0 = *(const uint4*)gb0, rb1 = *(const uint4*)gb1, rb2 = *(const uint4*)gb2, rb3 = *(const uint4*)gb3;
    for (int kt = 0; kt < K / 64; ++kt) {
      __syncthreads();
      *(uint4*)(sA + (c0 >> 3) * LDA + (c0 & 7) * 8) = ra0;
      *(uint4*)(sA + (c1 >> 3) * LDA + (c1 & 7) * 8) = ra1;
      *(uint4*)(sA + (c2 >> 3) * LDA + (c2 & 7) * 8) = ra2;
      *(uint4*)(sA + (c3 >> 3) * LDA + (c3 & 7) * 8) = ra3;
      *(uint4*)(sB + (c0 >> 3) * LDA + (c0 & 7) * 8) = rb0;
      *(uint4*)(sB + (c1 >> 3) * LDA + (c1 & 7) * 8) = rb1;
      *(uint4*)(sB + (c2 >> 3) * LDA + (c2 & 7) * 8) = rb2;
      *(uint4*)(sB + (c3 >> 3) * LDA + (c3 & 7) * 8) = rb3;
      __syncthreads();
      if (kt + 1 < K / 64) {
        const int k0 = (kt + 1) * 64;
        ra0 = *(const uint4*)(ga0 + k0); ra1 = *(const uint4*)(ga1 + k0); ra2 = *(const uint4*)(ga2 + k0); ra3 = *(const uint4*)(ga3 + k0);
        rb0 = *(const uint4*)(gb0 + k0); rb1 = *(const uint4*)(gb1 + k0); rb2 = *(const uint4*)(gb2 + k0); rb3 = *(const uint4*)(gb3 + k0);
      }
#pragma unroll
      for (int ks = 0; ks < 4; ++ks) {
        bf16x8 fa[2], fb[2];
#pragma unroll
        for (int i = 0; i < 2; ++i) {
          fa[i] = *(const bf16x8*)(sA + (wm * 64 + i * 32 + r) * LDA + ks * 16 + h * 8);
          fb[i] = *(const bf16x8*)(sB + (wn * 64 + i * 32 + r) * LDA + ks * 16 + h * 8);
        }
#pragma unroll
        for (int a = 0; a < 2; ++a)
#pragma unroll
          for (int b = 0; b < 2; ++b) {
            if (EPI == EPI_Q) acc[a][b] = __builtin_amdgcn_mfma_f32_32x32x16_bf16(fb[b], fa[a], acc[a][b], 0, 0, 0);
            else acc[a][b] = __builtin_amdgcn_mfma_f32_32x32x16_bf16(fa[a], fb[b], acc[a][b], 0, 0, 0);
          }
      }
    }
    const int nb0 = n0 + wn * 64;
    if (EPI == EPI_EVEN || EPI == EPI_ODD) {
      const bool rope = (EPI == EPI_EVEN) ? (nb0 >= 1536 && nb0 < 2560) : (nb0 < 1280);
      const bool is_v = (EPI == EPI_EVEN) ? ((nb0 >= 1024 && nb0 < 1536) || nb0 >= 2560) : (nb0 >= 1280);
      if (!is_v)
#pragma unroll
      for (int mi = 0; mi < 2; ++mi)
#pragma unroll
        for (int i = 0; i < 16; ++i) {
          const int m = m0 + wm * 64 + mi * 32 + (i & 3) + 8 * (i >> 2) + 4 * h;
          float t1 = acc[mi][0][i], t2 = acc[mi][1][i];
          if (rope) {
            const int pos = m & (S - 1);
            const float cs = p.ropec()[pos * 32 + r], sn = p.ropes()[pos * 32 + r];
            const float o1 = t1 * cs - t2 * sn, o2 = t1 * sn + t2 * cs;
            t1 = o1; t2 = o2;
          }
          const unsigned pk = pack2_hw(t1, t2);
          p.proj()[(size_t)m * N + nb0 + r] = (bf16_t)(pk & 0xffffu);
          p.proj()[(size_t)m * N + nb0 + 32 + r] = (bf16_t)(pk >> 16);
        }
      int nv0 = -1;
      if (EPI == EPI_EVEN) { if (nb0 >= 1024 && nb0 < 1536) nv0 = nb0 - 1024; else if (nb0 >= 2560) nv0 = nb0 - 2560 + 512; }
      else { if (nb0 >= 1280) nv0 = nb0 - 1280; }
      if (nv0 >= 0) {
#pragma unroll
        for (int mi = 0; mi < 2; ++mi)
#pragma unroll
          for (int ni = 0; ni < 2; ++ni)
#pragma unroll
            for (int g4 = 0; g4 < 4; ++g4) {
              const int m = m0 + wm * 64 + mi * 32 + 8 * g4 + 4 * h;
              const int b = m / S, s = m & (S - 1);
              *(uint2*)(p.vT() + ((size_t)b * 1024 + nv0 + ni * 32 + r) * S + s) =
                  make_uint2(pack2_hw(acc[mi][ni][g4 * 4 + 0], acc[mi][ni][g4 * 4 + 1]), pack2_hw(acc[mi][ni][g4 * 4 + 2], acc[mi][ni][g4 * 4 + 3]));
            }
      }
    } else if (EPI == EPI_OUT) {
      float gate_ni[2];
#pragma unroll
      for (int ni = 0; ni < 2; ++ni) gate_ni[ni] = p.mods()[((size_t)(layer * 2 + 0) * 2 + (m0 / S)) * 3072 + 2 * D + nb0 + ni * 32 + r];
#pragma unroll
      for (int mi = 0; mi < 2; ++mi)
#pragma unroll
        for (int ni = 0; ni < 2; ++ni)
#pragma unroll
          for (int i = 0; i < 16; ++i) {
            const int m = m0 + wm * 64 + mi * 32 + (i & 3) + 8 * (i >> 2) + 4 * h;
            const int n = nb0 + ni * 32 + r;
            __builtin_nontemporal_store(ALPHA * xres[(size_t)m * D + n] + gate_ni[ni] * acc[mi][ni][i], &p.zbuf()[(size_t)m * D + n]);
          }
    } else {
#if !FUSED_TOPK
#pragma unroll
      for (int a = 0; a < 2; ++a)
#pragma unroll
        for (int b = 0; b < 2; ++b)
#pragma unroll
          for (int i = 0; i < 16; ++i)
            p.qpeer()[(size_t)(m0 + wm * 64 + a * 32 + r) * 2048 + n0 + wn * 64 + b * 32 + (i & 3) + 8 * (i >> 2) + 4 * h] = acc[a][b][i];
      if (false) {
#else
      {
#endif
#if TOPK_SEPARATE
      {
        bf16_t* qb = (bf16_t*)p.qpeer();
#pragma unroll
        for (int a = 0; a < 2; ++a)
#pragma unroll
          for (int b = 0; b < 2; ++b)
#pragma unroll
            for (int g4 = 0; g4 < 4; ++g4)
              *(uint2*)(qb + (size_t)(m0 + wm * 64 + a * 32 + r) * 2048 + n0 + wn * 64 + b * 32 + 8 * g4 + 4 * h) =
                  make_uint2(pack2_hw(acc[a][b][g4 * 4 + 0], acc[a][b][g4 * 4 + 1]), pack2_hw(acc[a][b][g4 * 4 + 2], acc[a][b][g4 * 4 + 3]));
      }
      if (false) {
#else
      {
#endif
      constexpr int QS = 136;
      bf16_t* sQh = (bf16_t*)smem;
      bf16_t* sQl = sQh + 128 * QS;
      __syncthreads();
#pragma unroll
      for (int a = 0; a < 2; ++a)
#pragma unroll
        for (int b = 0; b < 2; ++b)
#pragma unroll
          for (int g4 = 0; g4 < 4; ++g4) {
            const float v0 = acc[a][b][g4 * 4 + 0], v1 = acc[a][b][g4 * 4 + 1], v2 = acc[a][b][g4 * 4 + 2], v3 = acc[a][b][g4 * 4 + 3];
            const unsigned h01 = pack2_hw(v0, v1), h23 = pack2_hw(v2, v3);
            const int off = (wm * 64 + a * 32 + r) * QS + wn * 64 + b * 32 + 8 * g4 + 4 * h;
            *(uint2*)(sQh + off) = make_uint2(h01, h23);
            *(uint2*)(sQl + off) = make_uint2(pack2_hw(v0 - bflo(h01), v1 - bfhi(h01)), pack2_hw(v2 - bflo(h23), v3 - bfhi(h23)));
          }
      __syncthreads();
      topk_from_sQ(p, layer, tn, m0, smem, tid, wm, wn, r, h);
      }
      }
    }
  }
}

struct OnlineSm {
  float m, l;
};

template <typename KeyFn>
DI void naive_attn_thread(const bf16_t* __restrict__ qptr, float m_init, float l_init, int nkeys, KeyFn keyfn, bf16_t* __restrict__ optr) {
  float q[64], acc[64];
#pragma unroll
  for (int c = 0; c < 8; ++c) {
    const uint4 u = *(const uint4*)(qptr + c * 8);
    q[c * 8 + 0] = bflo(u.x); q[c * 8 + 1] = bfhi(u.x); q[c * 8 + 2] = bflo(u.y); q[c * 8 + 3] = bfhi(u.y);
    q[c * 8 + 4] = bflo(u.z); q[c * 8 + 5] = bfhi(u.z); q[c * 8 + 6] = bflo(u.w); q[c * 8 + 7] = bfhi(u.w);
  }
#pragma unroll
  for (int d = 0; d < 64; ++d) acc[d] = 0.f;
  float mx = m_init, l = l_init;
  for (int kk = 0; kk < nkeys; ++kk) {
    const bf16_t *kp, *vp;
    float bias;
    bool valid;
    keyfn(kk, kp, vp, bias, valid);
    if (!valid) continue;
    float s = 0.f;
#pragma unroll
    for (int c = 0; c < 8; ++c) {
      const uint4 u = *(const uint4*)(kp + c * 8);
      s += q[c * 8 + 0] * bflo(u.x) + q[c * 8 + 1] * bfhi(u.x) + q[c * 8 + 2] * bflo(u.y) + q[c * 8 + 3] * bfhi(u.y) +
           q[c * 8 + 4] * bflo(u.z) + q[c * 8 + 5] * bfhi(u.z) + q[c * 8 + 6] * bflo(u.w) + q[c * 8 + 7] * bfhi(u.w);
    }
    s = s * 0.125f + bias;
    const float mn = fmaxf(mx, s);
    const float corr = __expf(mx - mn), pe = __expf(s - mn);
    l = l * corr + pe;
#pragma unroll
    for (int c = 0; c < 8; ++c) {
      const uint4 u = *(const uint4*)(vp + c * 8);
      acc[c * 8 + 0] = acc[c * 8 + 0] * corr + pe * bflo(u.x); acc[c * 8 + 1] = acc[c * 8 + 1] * corr + pe * bfhi(u.x);
      acc[c * 8 + 2] = acc[c * 8 + 2] * corr + pe * bflo(u.y); acc[c * 8 + 3] = acc[c * 8 + 3] * corr + pe * bfhi(u.y);
      acc[c * 8 + 4] = acc[c * 8 + 4] * corr + pe * bflo(u.z); acc[c * 8 + 5] = acc[c * 8 + 5] * corr + pe * bfhi(u.z);
      acc[c * 8 + 6] = acc[c * 8 + 6] * corr + pe * bflo(u.w); acc[c * 8 + 7] = acc[c * 8 + 7] * corr + pe * bfhi(u.w);
    }
    mx = mn;
  }
  const float inv = 1.0f / l;
#pragma unroll
  for (int c = 0; c < 8; ++c) {
    uint4 u;
    u.x = pack2(acc[c * 8 + 0] * inv, acc[c * 8 + 1] * inv); u.y = pack2(acc[c * 8 + 2] * inv, acc[c * 8 + 3] * inv);
    u.z = pack2(acc[c * 8 + 4] * inv, acc[c * 8 + 5] * inv); u.w = pack2(acc[c * 8 + 6] * inv, acc[c * 8 + 7] * inv);
    *(uint4*)(optr + c * 8) = u;
  }
}

DI void phase_attn_even_naive(const Params& p, int li, int tid_, int bid_) {
  const int tid = tid_;
  for (int tile = bid_; tile < M * 8 / NTHR; tile += gridDim.x) {
    const int idx = tile * NTHR + tid;
    const int head = idx & 7, token = idx >> 3;
    const int b = token / S, s = token & (S - 1), r = s >> 6, c = s & 63;
    const int rs = min(max(r - 4, 0), 128 - 8), csx = min(max(c - 8, 0), 64 - 16);
    const bf16_t* base = p.proj() + (size_t)b * S * EVEN_IN;
    const float* rp = p.rpb + (size_t)(li * 8 + head) * 15 * 31;
    auto keyfn = [&](int kk, const bf16_t*& kp, const bf16_t*& vp, float& bias, bool& valid) {
      const int kr = rs + (kk >> 4), kc = csx + (kk & 15);
      const size_t off = (size_t)(kr * 64 + kc) * EVEN_IN;
      kp = base + off + 512 + head * 64;
      vp = base + off + 1024 + head * 64;
      bias = rp[(kr - r + 7) * 31 + (kc - c + 15)];
      valid = true;
    };
    naive_attn_thread(p.proj() + (size_t)token * EVEN_IN + head * 64, -1e30f, 0.f, 128, keyfn, p.obuf() + (size_t)token * D + head * 64);
  }
  for (int tile = bid_; tile < (M / NTHR) * 32; tile += gridDim.x) {
    const int tt = tile >> 5, sub = tile & 31;
    const int hh = sub >> 3, mm = (sub >> 2) & 1, qt = sub & 3;
    const int token = tt * NTHR + tid;
    const int b = token / S;
    const bf16_t* base = p.proj() + (size_t)b * S * EVEN_IN;
    float q[64], acc[32];
    const bf16_t* qptr = p.proj() + (size_t)token * EVEN_IN + 1536 + hh * 128 + mm * 64;
#pragma unroll
    for (int c = 0; c < 8; ++c) {
      const uint4 u = *(const uint4*)(qptr + c * 8);
      q[c * 8 + 0] = bflo(u.x); q[c * 8 + 1] = bfhi(u.x); q[c * 8 + 2] = bflo(u.y); q[c * 8 + 3] = bfhi(u.y);
      q[c * 8 + 4] = bflo(u.z); q[c * 8 + 5] = bfhi(u.z); q[c * 8 + 6] = bflo(u.w); q[c * 8 + 7] = bfhi(u.w);
    }
#pragma unroll
    for (int d = 0; d < 32; ++d) acc[d] = 0.f;
    float mx = -1e30f, l = 0.f;
    for (int key = 0; key < S; ++key) {
      const bf16_t* kp = base + (size_t)key * EVEN_IN + 2048 + hh * 128 + mm * 64;
      const bf16_t* vp = base + (size_t)key * EVEN_IN + 2560 + hh * 128 + qt * 32;
      float sdot = 0.f;
#pragma unroll
      for (int c = 0; c < 8; ++c) {
        const uint4 u = *(const uint4*)(kp + c * 8);
        sdot += q[c * 8 + 0] * bflo(u.x) + q[c * 8 + 1] * bfhi(u.x) + q[c * 8 + 2] * bflo(u.y) + q[c * 8 + 3] * bfhi(u.y) +
                q[c * 8 + 4] * bflo(u.z) + q[c * 8 + 5] * bfhi(u.z) + q[c * 8 + 6] * bflo(u.w) + q[c * 8 + 7] * bfhi(u.w);
      }
      sdot *= 0.125f;
      const float mn = fmaxf(mx, sdot);
      const float corr = __expf(mx - mn), pe = __expf(sdot - mn);
      l = l * corr + pe;
#pragma unroll
      for (int c = 0; c < 4; ++c) {
        const uint4 u = *(const uint4*)(vp + c * 8);
        acc[c * 8 + 0] = acc[c * 8 + 0] * corr + pe * bflo(u.x); acc[c * 8 + 1] = acc[c * 8 + 1] * corr + pe * bfhi(u.x);
        acc[c * 8 + 2] = acc[c * 8 + 2] * corr + pe * bflo(u.y); acc[c * 8 + 3] = acc[c * 8 + 3] * corr + pe * bfhi(u.y);
        acc[c * 8 + 4] = acc[c * 8 + 4] * corr + pe * bflo(u.z); acc[c * 8 + 5] = acc[c * 8 + 5] * corr + pe * bfhi(u.z);
        acc[c * 8 + 6] = acc[c * 8 + 6] * corr + pe * bflo(u.w); acc[c * 8 + 7] = acc[c * 8 + 7] * corr + pe * bfhi(u.w);
      }
      mx = mn;
    }
    const float inv = 1.0f / l;
    float* op = p.dtmp() + (((size_t)mm * M + token) * 4 + hh) * 128 + qt * 32;
#pragma unroll
    for (int d = 0; d < 32; d += 4) *(float4*)(op + d) = make_float4(acc[d] * inv, acc[d + 1] * inv, acc[d + 2] * inv, acc[d + 3] * inv);
  }
}

DI void phase_diff_combine(const Params& p, int li, int tid_, int bid_) {
  const float lam = p.lam()[li], linit = p.lam()[2 + li];
  for (int idx = bid_ * NTHR + tid_; idx < M * 4; idx += gridDim.x * NTHR) {
    const int token = idx >> 2, hh = idx & 3;
    const float* o0 = p.dtmp() + ((size_t)token * 4 + hh) * 128;
    const float* o1 = p.dtmp() + (((size_t)M + token) * 4 + hh) * 128;
    float ss = 0.f;
    for (int d = 0; d < 128; ++d) {
      const float o = o0[d] - lam * o1[d];
      ss += o * o;
    }
    const float rs = rsqrtf(ss * (1.0f / 128.f) + LN_EPS) * (1.0f - linit);
    bf16_t* op = p.obuf() + (size_t)token * D + 512 + hh * 128;
    for (int d = 0; d < 128; ++d) {
      const float o = o0[d] - lam * o1[d];
      op[d] = f2bf(o * rs * p.sub_g[li * 128 + d]);
    }
  }
}

DI void phase_attn_odd_naive(const Params& p, int lj, int tid_, int bid_) {
  const int tid = tid_;
  for (int tile = bid_; tile < M * 16 / NTHR; tile += gridDim.x) {
    const int idx = tile * NTHR + tid;
    const int head = idx & 15, token = idx >> 4;
    const int b = token / S, s = token & (S - 1);
    const int k_lo = max(s - 128, 0), k_hi = min(s + 128, S - 1);
    const bf16_t* base = p.proj() + (size_t)b * S * ODD_IN;
    const int kvh = head >> 2;
    auto keyfn = [&](int kk, const bf16_t*& kp, const bf16_t*& vp, float& bias, bool& valid) {
      const size_t off = (size_t)(k_lo + kk) * ODD_IN;
      kp = base + off + 1024 + kvh * 64;
      vp = base + off + 1280 + kvh * 64;
      bias = 0.f;
      valid = true;
    };
    naive_attn_thread(p.proj() + (size_t)token * ODD_IN + head * 64, p.sink[lj * 16 + head], 1.0f, k_hi - k_lo + 1, keyfn,
                      p.obuf() + (size_t)token * D + head * 64);
  }
}


#define MFMA32(a, b, c) __builtin_amdgcn_mfma_f32_32x32x16_bf16((a), (b), (c), 0, 0, 0)
constexpr float LOG2E = 1.4426950408889634f;
constexpr int VS = 68;

DI bf16x8 pack8(float a0, float a1, float a2, float a3, float a4, float a5, float a6, float a7) {
  u32x4 pk;
  asm volatile("v_cvt_pk_bf16_f32 %0, %4, %5\n\tv_cvt_pk_bf16_f32 %1, %6, %7\n\tv_cvt_pk_bf16_f32 %2, %8, %9\n\tv_cvt_pk_bf16_f32 %3, %10, %11\n\ts_nop 1"
               : "=&v"(pk[0]), "=&v"(pk[1]), "=&v"(pk[2]), "=&v"(pk[3])
               : "v"(a0), "v"(a1), "v"(a2), "v"(a3), "v"(a4), "v"(a5), "v"(a6), "v"(a7));
  return __builtin_bit_cast(bf16x8, pk);
}

template <int NDT, int KS, bool FOLD = false, typename MaskFn>
DI void attn_tile(const bf16_t* sKw, const bf16_t* sV, const bf16x8 (&qf)[2][4], f32x16 (&o)[2][NDT], float (&mrow)[2], float (&lrow)[2], int r, int h,
                  MaskFn&& mask, float fold_sc = 1.0f) {
#pragma unroll 1
  for (int sub = 0; sub < 2; ++sub) {
    f32x16 s[2];
#pragma unroll
    for (int i = 0; i < 16; ++i) { s[0][i] = 0.f; s[1][i] = 0.f; }
#pragma unroll
    for (int ks = 0; ks < 4; ++ks) {
      const bf16x8 kf = *(const bf16x8*)(sKw + (sub * 32 + r) * KS + ks * 16 + h * 8);
      s[0] = MFMA32(kf, qf[0][ks], s[0]);
      s[1] = MFMA32(kf, qf[1][ks], s[1]);
    }
    bf16x8 pf[2][2];
#pragma unroll
    for (int qt = 0; qt < 2; ++qt) {
      float mx = -INFINITY;
#pragma unroll
      for (int i = 0; i < 16; ++i) {
        const float v = mask(qt, sub, i, s[qt][i]);
        s[qt][i] = v;
        mx = fmaxf(mx, v);
      }
      mx = xhalf_max(mx);
      if (FOLD) mx *= fold_sc;
      const float mn = fmaxf(mrow[qt], mx);
      const float corr = __builtin_amdgcn_exp2f(mrow[qt] - mn);
      mrow[qt] = mn;
      float rs = 0.f;
#pragma unroll
      for (int i = 0; i < 16; ++i) {
        const float pv = __builtin_amdgcn_exp2f(FOLD ? __builtin_fmaf(s[qt][i], fold_sc, -mn) : (s[qt][i] - mn));
        s[qt][i] = pv;
        rs += pv;
      }
      lrow[qt] = lrow[qt] * corr + rs;
      if (__builtin_amdgcn_ballot_w64(corr != 1.0f) != 0ull) {
#pragma unroll
        for (int dt = 0; dt < NDT; ++dt)
#pragma unroll
          for (int i = 0; i < 16; ++i) o[qt][dt][i] *= corr;
      }
      pf[qt][0] = pack8(s[qt][0], s[qt][1], s[qt][2], s[qt][3], s[qt][4], s[qt][5], s[qt][6], s[qt][7]);
      pf[qt][1] = pack8(s[qt][8], s[qt][9], s[qt][10], s[qt][11], s[qt][12], s[qt][13], s[qt][14], s[qt][15]);
    }
#pragma unroll
    for (int sp = 0; sp < 2; ++sp) {
#pragma unroll
      for (int dt = 0; dt < NDT; ++dt) {
        const bf16_t* vp = sV + (dt * 32 + r) * VS + (sub * 2 + sp) * 16 + 4 * h;
        const uint2 lo = *(const uint2*)vp;
        const uint2 hi = *(const uint2*)(vp + 8);
        u32x4 vv; vv[0] = lo.x; vv[1] = lo.y; vv[2] = hi.x; vv[3] = hi.y;
        const bf16x8 vf = __builtin_bit_cast(bf16x8, vv);
        o[0][dt] = MFMA32(vf, pf[0][sp], o[0][dt]);
        o[1][dt] = MFMA32(vf, pf[1][sp], o[1][dt]);
      }
    }
  }
}

DI void lds_put16(bf16_t* dst8, uint4 v) {
  *(uint2*)dst8 = make_uint2(v.x, v.y);
  *(uint2*)(dst8 + 4) = make_uint2(v.z, v.w);
}

DI void phase_diff_mfma(const Params& p, int li, char* smem, int tid_, int bid_) {
  constexpr int KS = 136;
  bf16_t* sK = (bf16_t*)smem;
  bf16_t* sV = sK + 64 * KS;
  const int tid = tid_, lane = tid & 63, wave = tid >> 6, r = lane & 31, h = lane >> 5;
  const int comp = wave & 1, qg = wave >> 1;
  const float sc = 0.125f * LOG2E;
  for (int item = bid_; item < 512; item += gridDim.x) {
    const int bh = item & 7, b = bh >> 2, hh = bh & 3, q0 = (item >> 3) * 128 + qg * 64;
    const bf16_t* kbase = p.proj() + (size_t)b * S * EVEN_IN + 2048 + hh * 128;
    const bf16_t* vbase = p.vT() + ((size_t)b * 1024 + 512 + hh * 128) * S;
    bf16x8 qf[2][4];
    {
    int tq = tid_;
    asm volatile("" : "+v"(tq));
    const int r = tq & 31, h = (tq >> 5) & 1;
#pragma unroll
    for (int qt = 0; qt < 2; ++qt)
#pragma unroll
      for (int ks = 0; ks < 4; ++ks)
        qf[qt][ks] = *(const bf16x8*)(p.proj() + (size_t)(b * S + q0 + qt * 32 + r) * EVEN_IN + 1536 + hh * 128 + comp * 64 + ks * 16 + h * 8);
    }
    f32x16 o[2][4];
#pragma unroll
    for (int a = 0; a < 2; ++a)
#pragma unroll
      for (int d = 0; d < 4; ++d)
#pragma unroll
        for (int i = 0; i < 16; ++i) o[a][d][i] = 0.f;
    float mrow[2] = {-1e30f, -1e30f}, lrow[2] = {0.f, 0.f};
    for (int t = 0; t < S / 64; ++t) {
      int tl = tid;
      asm volatile("" : "+v"(tl));
      const int c0 = tl, c1 = tl + 256, c2 = tl + 512, c3 = tl + 768;
      const bf16_t* kt_ = kbase + (size_t)t * 64 * EVEN_IN;
      const bf16_t* vt_ = vbase + t * 64;
      const uint4 k0 = *(const uint4*)(kt_ + (c0 >> 4) * EVEN_IN + (c0 & 15) * 8);
      const uint4 k1 = *(const uint4*)(kt_ + (c1 >> 4) * EVEN_IN + (c1 & 15) * 8);
      const uint4 k2 = *(const uint4*)(kt_ + (c2 >> 4) * EVEN_IN + (c2 & 15) * 8);
      const uint4 k3 = *(const uint4*)(kt_ + (c3 >> 4) * EVEN_IN + (c3 & 15) * 8);
      const uint4 v0 = *(const uint4*)(vt_ + (c0 >> 3) * S + (c0 & 7) * 8);
      const uint4 v1 = *(const uint4*)(vt_ + (c1 >> 3) * S + (c1 & 7) * 8);
      const uint4 v2 = *(const uint4*)(vt_ + (c2 >> 3) * S + (c2 & 7) * 8);
      const uint4 v3 = *(const uint4*)(vt_ + (c3 >> 3) * S + (c3 & 7) * 8);
      __syncthreads();
      *(uint4*)(sK + (c0 >> 4) * KS + (c0 & 15) * 8) = k0;
      *(uint4*)(sK + (c1 >> 4) * KS + (c1 & 15) * 8) = k1;
      *(uint4*)(sK + (c2 >> 4) * KS + (c2 & 15) * 8) = k2;
      *(uint4*)(sK + (c3 >> 4) * KS + (c3 & 15) * 8) = k3;
      lds_put16(sV + (c0 >> 3) * VS + (c0 & 7) * 8, v0);
      lds_put16(sV + (c1 >> 3) * VS + (c1 & 7) * 8, v1);
      lds_put16(sV + (c2 >> 3) * VS + (c2 & 7) * 8, v2);
      lds_put16(sV + (c3 >> 3) * VS + (c3 & 7) * 8, v3);
      __syncthreads();
      attn_tile<4, KS, true>(sK + comp * 64, sV, qf, o, mrow, lrow, r, h, [&](int, int, int, float raw) { return raw; }, sc);
    }
    int tf = tid_;
    asm volatile("" : "+v"(tf));
    const int lane = tf & 63, r = tf & 31, h = (tf >> 5) & 1;
    const float lam = p.lam()[li], linit = p.lam()[2 + li];
    float inv[2];
#pragma unroll
    for (int qt = 0; qt < 2; ++qt) inv[qt] = 1.0f / xhalf_sum(lrow[qt]);
    float* ex = (float*)smem + qg * 4096;
    float ss[2] = {0.f, 0.f};
#pragma unroll
    for (int pass = 0; pass < 2; ++pass) {
      __syncthreads();
      if (comp == 1) {
#pragma unroll
        for (int qt = 0; qt < 2; ++qt)
#pragma unroll
          for (int d2 = 0; d2 < 2; ++d2)
#pragma unroll
            for (int i = 0; i < 16; ++i) ex[((qt * 2 + d2) * 16 + i) * 64 + lane] = o[qt][pass * 2 + d2][i] * inv[qt];
      }
      __syncthreads();
      if (comp == 0) {
#pragma unroll
        for (int qt = 0; qt < 2; ++qt)
#pragma unroll
          for (int d2 = 0; d2 < 2; ++d2)
#pragma unroll
            for (int i = 0; i < 16; ++i) {
              const float v = o[qt][pass * 2 + d2][i] * inv[qt] - lam * ex[((qt * 2 + d2) * 16 + i) * 64 + lane];
              o[qt][pass * 2 + d2][i] = v;
              ss[qt] += v * v;
            }
      }
    }
    if (comp == 0) {
#pragma unroll
      for (int qt = 0; qt < 2; ++qt) {
        const float tot = xhalf_sum(ss[qt]);
        const float rs = rsqrtf(tot * (1.0f / 128.f) + LN_EPS) * (1.0f - linit);
        bf16_t* op = p.obuf() + (size_t)(b * S + q0 + qt * 32 + r) * D + 512 + hh * 128;
#pragma unroll
        for (int dt = 0; dt < 4; ++dt)
#pragma unroll
          for (int g4 = 0; g4 < 4; ++g4) {
            const int d = dt * 32 + 8 * g4 + 4 * h;
            const float4 sg = *(const float4*)(p.sub_g + li * 128 + d);
            *(uint2*)(op + d) = make_uint2(pack2_hw(o[qt][dt][g4 * 4 + 0] * rs * sg.x, o[qt][dt][g4 * 4 + 1] * rs * sg.y),
                                           pack2_hw(o[qt][dt][g4 * 4 + 2] * rs * sg.z, o[qt][dt][g4 * 4 + 3] * rs * sg.w));
          }
      }
    }
    __syncthreads();
  }
}

constexpr int KS64 = 72;

template <int NDT>
DI void attn64_store_out(const Params& p, f32x16 (&o)[2][NDT], const float (&lrow)[2], int tok0, int col0, int r, int h) {
#pragma unroll
  for (int qt = 0; qt < 2; ++qt) {
    const float inv = 1.0f / xhalf_sum(lrow[qt]);
    bf16_t* op = p.obuf() + (size_t)(tok0 + qt * 32 + r) * D + col0;
#pragma unroll
    for (int dt = 0; dt < NDT; ++dt)
#pragma unroll
      for (int g4 = 0; g4 < 4; ++g4) {
        const int d = dt * 32 + 8 * g4 + 4 * h;
        *(uint2*)(op + d) = make_uint2(pack2_hw(o[qt][dt][g4 * 4 + 0] * inv, o[qt][dt][g4 * 4 + 1] * inv),
                                       pack2_hw(o[qt][dt][g4 * 4 + 2] * inv, o[qt][dt][g4 * 4 + 3] * inv));
      }
  }
}

DI void phase_na_mfma(const Params& p, int li, char* smem, int tid_, int bid_) {
  bf16_t* sK = (bf16_t*)smem;
  bf16_t* sV = sK + 64 * KS64;
  float* sBias = (float*)(sV + 64 * VS);
  const int tid = tid_, lane = tid & 63, wave = tid >> 6, r = lane & 31, h = lane >> 5;
  const float sc = 0.125f * LOG2E;
  for (int item = bid_; item < 2 * 8 * 32; item += gridDim.x) {
    const int bh = item & 15, b = bh >> 3, head = bh & 7, r0 = (item >> 4) * 4;
    const int row = r0 + wave;
    const int rs_w = min(max(row - 4, 0), 120);
    const int kr_lo = min(max(r0 - 4, 0), 120), kr_hi = min(max(r0 + 3 - 4, 0), 120) + 7;
    const bf16_t* kbase = p.proj() + (size_t)b * S * EVEN_IN + 512 + head * 64;
    const bf16_t* vbase = p.vT() + ((size_t)b * 1024 + head * 64) * S;
    __syncthreads();
    for (int i = tid; i < 15 * 32; i += NTHR) {
      const int dr = i >> 5, dc = i & 31;
      sBias[i] = (dc < 31) ? p.rpb[((size_t)(li * 8 + head) * 15 + dr) * 31 + dc] * LOG2E : 0.f;
    }
    bf16x8 qf[2][4];
#pragma unroll
    for (int qt = 0; qt < 2; ++qt)
#pragma unroll
      for (int ks = 0; ks < 4; ++ks)
        qf[qt][ks] = *(const bf16x8*)(p.proj() + (size_t)(b * S + row * 64 + qt * 32 + r) * EVEN_IN + head * 64 + ks * 16 + h * 8);
    f32x16 o[2][2];
#pragma unroll
    for (int a = 0; a < 2; ++a)
#pragma unroll
      for (int d = 0; d < 2; ++d)
#pragma unroll
        for (int i = 0; i < 16; ++i) o[a][d][i] = 0.f;
    float mrow[2] = {-1e30f, -1e30f}, lrow[2] = {0.f, 0.f};
    const int c0 = tid, c1 = tid + 256;
    const bf16_t* gk0 = kbase + (size_t)(c0 >> 3) * EVEN_IN + (c0 & 7) * 8;
    const bf16_t* gk1 = kbase + (size_t)(c1 >> 3) * EVEN_IN + (c1 & 7) * 8;
    const bf16_t* gv0 = vbase + (size_t)(c0 >> 3) * S + (c0 & 7) * 8;
    const bf16_t* gv1 = vbase + (size_t)(c1 >> 3) * S + (c1 & 7) * 8;
    for (int kr = kr_lo; kr <= kr_hi; ++kr) {
      const size_t ko = (size_t)kr * 64 * EVEN_IN;
      const int vo = kr * 64;
      const uint4 k0 = *(const uint4*)(gk0 + ko), k1 = *(const uint4*)(gk1 + ko);
      const uint4 v0 = *(const uint4*)(gv0 + vo), v1 = *(const uint4*)(gv1 + vo);
      __syncthreads();
      *(uint4*)(sK + (c0 >> 3) * KS64 + (c0 & 7) * 8) = k0;
      *(uint4*)(sK + (c1 >> 3) * KS64 + (c1 & 7) * 8) = k1;
      lds_put16(sV + (c0 >> 3) * VS + (c0 & 7) * 8, v0);
      lds_put16(sV + (c1 >> 3) * VS + (c1 & 7) * 8, v1);
      __syncthreads();
      int rr = r, hh2 = h;
      asm volatile("" : "+v"(rr), "+v"(hh2));
      if (kr >= rs_w && kr < rs_w + 8) {
        const float* brow = sBias + (kr - row + 7) * 32;
        attn_tile<2, KS64>(sK, sV, qf, o, mrow, lrow, r, h, [&](int qt, int sub, int i, float raw) {
          const int qc = qt * 32 + rr, kc = sub * 32 + (i & 3) + 8 * (i >> 2) + 4 * hh2;
          const int cs = min(max(qc - 8, 0), 48);
          const bool ok = (kc >= cs) && (kc < cs + 16);
          const int dc = min(max(kc - qc + 15, 0), 30);
          return ok ? raw * sc + brow[dc] : -INFINITY;
        });
      }
    }
    attn64_store_out<2>(p, o, lrow, b * S + row * 64, head * 64, r, h);
  }
}

DI void phase_swa_mfma(const Params& p, int lj, char* smem, int tid_, int bid_) {
  bf16_t* sK = (bf16_t*)smem;
  bf16_t* sV = sK + 64 * KS64;
  const int tid = tid_, lane = tid & 63, wave = tid >> 6, r = lane & 31, h = lane >> 5;
  const float sc = 0.125f * LOG2E;
  for (int item = bid_; item < 2 * 4 * 128; item += gridDim.x) {
    const int bh = item & 7, b = bh >> 2, kvh = bh & 3, qg = item >> 3, q0 = qg * 64;
    const int head = kvh * 4 + wave;
    const int t_lo = max(qg - 2, 0), t_hi = min(qg + 2, S / 64 - 1);
    const bf16_t* kbase = p.proj() + (size_t)b * S * ODD_IN + 1024 + kvh * 64;
    const bf16_t* vbase = p.vT() + ((size_t)b * 1024 + kvh * 64) * S;
    bf16x8 qf[2][4];
#pragma unroll
    for (int qt = 0; qt < 2; ++qt)
#pragma unroll
      for (int ks = 0; ks < 4; ++ks)
        qf[qt][ks] = *(const bf16x8*)(p.proj() + (size_t)(b * S + q0 + qt * 32 + r) * ODD_IN + head * 64 + ks * 16 + h * 8);
    f32x16 o[2][2];
#pragma unroll
    for (int a = 0; a < 2; ++a)
#pragma unroll
      for (int d = 0; d < 2; ++d)
#pragma unroll
        for (int i = 0; i < 16; ++i) o[a][d][i] = 0.f;
    const float sk = p.sink[lj * 16 + head] * LOG2E;
    float mrow[2] = {sk, sk}, lrow[2] = {h == 0 ? 1.f : 0.f, h == 0 ? 1.f : 0.f};
    const int c0 = tid, c1 = tid + 256;
    const bf16_t* gk0 = kbase + (size_t)(c0 >> 3) * ODD_IN + (c0 & 7) * 8;
    const bf16_t* gk1 = kbase + (size_t)(c1 >> 3) * ODD_IN + (c1 & 7) * 8;
    const bf16_t* gv0 = vbase + (size_t)(c0 >> 3) * S + (c0 & 7) * 8;
    const bf16_t* gv1 = vbase + (size_t)(c1 >> 3) * S + (c1 & 7) * 8;
    for (int t = t_lo; t <= t_hi; ++t) {
      const size_t ko = (size_t)t * 64 * ODD_IN;
      const int vo = t * 64;
      const uint4 k0 = *(const uint4*)(gk0 + ko), k1 = *(const uint4*)(gk1 + ko);
      const uint4 v0 = *(const uint4*)(gv0 + vo), v1 = *(const uint4*)(gv1 + vo);
      __syncthreads();
      *(uint4*)(sK + (c0 >> 3) * KS64 + (c0 & 7) * 8) = k0;
      *(uint4*)(sK + (c1 >> 3) * KS64 + (c1 & 7) * 8) = k1;
      lds_put16(sV + (c0 >> 3) * VS + (c0 & 7) * 8, v0);
      lds_put16(sV + (c1 >> 3) * VS + (c1 & 7) * 8, v1);
      __syncthreads();
      int rr = r, hh2 = h;
      asm volatile("" : "+v"(rr), "+v"(hh2));
      const int kp0 = t * 64;
      attn_tile<2, KS64, true>(sK, sV, qf, o, mrow, lrow, r, h, [&](int qt, int sub, int i, float raw) {
        const int qp = q0 + qt * 32 + rr, kp = kp0 + sub * 32 + (i & 3) + 8 * (i >> 2) + 4 * hh2;
        const int dd = qp - kp;
        return (dd <= 128 && dd >= -128) ? raw : -INFINITY;
      }, sc);
    }
    attn64_store_out<2>(p, o, lrow, b * S + q0, head * 64, r, h);
    __syncthreads();
  }
}

DI void phase_peer_topk(const Params& p, int layer, char* smem, int tid_, int bid_) {
  float (*qs)[128] = (float (*)[128])smem;
  float (*sc)[129] = (float (*)[129])(smem + 32 * 128 * 4);
  const int tid = tid_;
  for (int tile = bid_; tile < (M / 32) * 16; tile += gridDim.x) {
    const int hp = tile & 15, tg = tile >> 4;
    const int t0 = tg * 32;
    __syncthreads();
#pragma unroll
    for (int i = 0; i < 4; ++i) {
      const int idx = tid + i * 256;
      const int rr = idx >> 5, cc = idx & 31;
      *(float4*)(&qs[rr][cc * 4]) = *(const float4*)(p.qpeer() + (size_t)(t0 + rr) * 2048 + hp * 128 + cc * 4);
    }
    __syncthreads();
    const int n = tid & 127, g = tid >> 7;
    const float* kt = p.dtmp() + ((size_t)(layer * 16 + hp) * 128) * 128 + n;
    float a[16];
#pragma unroll
    for (int t = 0; t < 16; ++t) a[t] = 0.f;
    for (int e = 0; e < 128; ++e) {
      const float kv = kt[(size_t)e * 128];
#pragma unroll
      for (int t = 0; t < 16; ++t) a[t] += qs[g * 16 + t][e] * kv;
    }
#pragma unroll
    for (int t = 0; t < 16; ++t) sc[g * 16 + t][n] = a[t];
    __syncthreads();
    if (tid < 32) {
      unsigned keys[16];
#pragma unroll
      for (int j = 0; j < 16; ++j) keys[j] = 0u;
      for (int nn = 0; nn < 128; ++nn) {
        unsigned k = (ordkey(sc[tid][nn]) & ~127u) | (unsigned)(127 - nn);
#pragma unroll
        for (int j = 0; j < 16; ++j) {
          const unsigned hi = max(keys[j], k);
          k = min(keys[j], k);
          keys[j] = hi;
        }
      }
      const size_t ob = ((size_t)(t0 + tid) * 16 + hp) * 16;
#pragma unroll
      for (int j = 0; j < 16; ++j) {
        const int id = 127 - (int)(keys[j] & 127u);
        p.si()[ob + j] = id;
        p.sv()[ob + j] = sc[tid][id];
      }
    }
  }
}

DI void phase_peer_final(const Params& p, int layer, char* smem, int tid_, int bid_) {
  const int lane = tid_ & 63, wave = tid_ >> 6;
  int* le = (int*)(smem + wave * 1024);
  float* lg = (float*)(smem + wave * 1024 + 512);
  const unsigned char* ub = (const unsigned char*)p.u_bf() + (size_t)layer * NEXP * D;
  const unsigned char* vb = (const unsigned char*)p.v_bf() + (size_t)layer * NEXP * D;
  const float* g = p.ln_g + (size_t)(layer * 2 + 1) * D;
  const float* be = p.ln_b + (size_t)(layer * 2 + 1) * D;
  const bool last = (layer == DEPTH - 1);
  float* dstx = last ? p.out : p.x2buf();
  const int lane0_ = lane;
  for (int token = bid_ * 4 + wave; token < M; token += gridDim.x * 4) {
    int lane = lane0_;
    asm volatile("" : "+v"(lane));
    const int b = token / S;
    {
      const int head = lane & 7;
      const size_t b0 = ((size_t)token * 16 + head * 2) * 16;
      float* svl = (float*)(smem + 4096 + wave * 2304);
      int* sil = (int*)(smem + 4096 + wave * 2304 + 1152);
      {
        const int qq = lane >> 3;
        const float4 tv = *(const float4*)(p.sv() + b0 + qq * 4);
        const int4 ti = *(const int4*)(p.si() + b0 + qq * 4);
        float* dv = svl + head * 33 + qq * 4;
        int* di = sil + head * 33 + qq * 4;
        dv[0] = tv.x; dv[1] = tv.y; dv[2] = tv.z; dv[3] = tv.w;
        di[0] = ti.x; di[1] = ti.y; di[2] = ti.z; di[3] = ti.w;
      }
      __builtin_amdgcn_wave_barrier();
      const float* sv0 = svl + head * 33;
      const int* si0 = sil + head * 33;
      unsigned keys[16];
#pragma unroll
      for (int j = 0; j < 16; ++j) keys[j] = 0u;
      for (int i = 0; i < 16; ++i) {
        const float a = sv0[i];
        const int jmax = 16 / (i + 1);
        for (int j = 0; j < jmax; ++j) {
          const float c = sv0[16 + j];
          unsigned k = (ordkey(a + c) & ~255u) | (unsigned)(255 - (i * 16 + j));
#pragma unroll
          for (int q = 0; q < 16; ++q) {
            const unsigned hi = max(keys[q], k);
            k = min(keys[q], k);
            keys[q] = hi;
          }
        }
      }
      float ex[16], sum = 0.f;
      float fmax_ = 0.f;
#pragma unroll
      for (int q = 0; q < 16; ++q) {
        const int flat = 255 - (int)(keys[q] & 255u);
        const float val = sv0[flat >> 4] + sv0[16 + (flat & 15)];
        if (q == 0) fmax_ = val;
        ex[q] = __expf(val - fmax_);
        sum += ex[q];
      }
      const float inv = 1.0f / sum;
      __builtin_amdgcn_wave_barrier();
      if (lane < 8) {
#pragma unroll
        for (int q = 0; q < 16; ++q) {
          const int flat = 255 - (int)(keys[q] & 255u);
          const int e = si0[flat >> 4] * 128 + si0[16 + (flat & 15)];
          le[head * 16 + q] = e;
          lg[head * 16 + q] = ex[q] * inv;
        }
      }
      __builtin_amdgcn_wave_barrier();
    }
    __syncthreads();
    float x1[16], h2[16], y[16];
    const float* mb = p.mods() + ((size_t)(layer * 2 + 1) * 2 + b) * 3072;
    float4 zv[4];
    {
      float s1 = 0.f;
#pragma unroll
      for (int q = 0; q < 4; ++q) {
        zv[q] = *(const float4*)(p.zbuf() + (size_t)token * D + lane * 16 + q * 4);
        s1 += zv[q].x + zv[q].y + zv[q].z + zv[q].w;
      }
      const float mu1 = wave_sum(s1) * (1.0f / D);
      float q1 = 0.f;
#pragma unroll
      for (int q = 0; q < 4; ++q) {
        zv[q].x -= mu1; zv[q].y -= mu1; zv[q].z -= mu1; zv[q].w -= mu1;
        q1 += zv[q].x * zv[q].x + zv[q].y * zv[q].y + zv[q].z * zv[q].z + zv[q].w * zv[q].w;
      }
      const float rstd1 = rsqrtf(wave_sum(q1) * (1.0f / D) + LN_EPS);
      const float* g1 = p.ln_g + (size_t)(layer * 2) * D;
      const float* b1 = p.ln_b + (size_t)(layer * 2) * D;
#pragma unroll
      for (int q = 0; q < 4; ++q) {
        const float4 gg = *(const float4*)(g1 + lane * 16 + q * 4);
        const float4 bb = *(const float4*)(b1 + lane * 16 + q * 4);
        zv[q].x = zv[q].x * rstd1 * gg.x + bb.x; zv[q].y = zv[q].y * rstd1 * gg.y + bb.y;
        zv[q].z = zv[q].z * rstd1 * gg.z + bb.z; zv[q].w = zv[q].w * rstd1 * gg.w + bb.w;
      }
    }
#pragma unroll
    for (int q = 0; q < 4; ++q) {
      const int e0 = lane * 16 + q * 4;
      const float4 xv = zv[q];
      const float4 sh = *(const float4*)(mb + e0);
      const float4 scl = *(const float4*)(mb + D + e0);
      const int o = q * 4;
      x1[o] = xv.x; x1[o + 1] = xv.y; x1[o + 2] = xv.z; x1[o + 3] = xv.w;
      h2[o] = xv.x * (1.f + scl.x) + sh.x; h2[o + 1] = xv.y * (1.f + scl.y) + sh.y;
      h2[o + 2] = xv.z * (1.f + scl.z) + sh.z; h2[o + 3] = xv.w * (1.f + scl.w) + sh.w;
    }
#pragma unroll
    for (int i = 0; i < 16; ++i) y[i] = 0.f;
#pragma unroll 1
    for (int hd = 0; hd < 8; ++hd) {
      u32x4 ur[16], vr[16];
#pragma unroll
      for (int k = 0; k < 16; ++k) {
        const unsigned eo = (unsigned)le[hd * 16 + k] * (unsigned)D + (unsigned)lane * 16u;
        ur[k] = *(const u32x4*)(ub + eo);
        vr[k] = *(const u32x4*)(vb + eo);
      }
      float av = 0.f;
#pragma unroll
      for (int k = 0; k < 16; ++k) {
        float d = 0.f;
#pragma unroll
        for (int w4 = 0; w4 < 4; ++w4) {
          const auto lo = __builtin_amdgcn_cvt_pk_f32_fp8((int)ur[k][w4], false);
          const auto hi = __builtin_amdgcn_cvt_pk_f32_fp8((int)ur[k][w4], true);
          d += h2[w4 * 4 + 0] * lo[0] + h2[w4 * 4 + 1] * lo[1] + h2[w4 * 4 + 2] * hi[0] + h2[w4 * 4 + 3] * hi[1];
        }
        const float tot = wave_sum(d);
        av = (lane == k) ? tot : av;
      }
      av *= (1.0f / U_SCALE);
      const float gel = 0.5f * av * (1.0f + erff(av * 0.70710678118654752f));
      const float wv = lg[hd * 16 + (lane & 15)] * gel * (1.0f / V_SCALE);
#pragma unroll
      for (int k = 0; k < 16; ++k) {
        const float w = __int_as_float(__builtin_amdgcn_readlane(__float_as_int(wv), k));
#pragma unroll
        for (int w4 = 0; w4 < 4; ++w4) {
          const auto lo = __builtin_amdgcn_cvt_pk_f32_fp8((int)vr[k][w4], false);
          const auto hi = __builtin_amdgcn_cvt_pk_f32_fp8((int)vr[k][w4], true);
          y[w4 * 4 + 0] += w * lo[0]; y[w4 * 4 + 1] += w * lo[1]; y[w4 * 4 + 2] += w * hi[0]; y[w4 * 4 + 3] += w * hi[1];
        }
      }
    }
    float z[16], s = 0.f;
#pragma unroll
    for (int q = 0; q < 4; ++q) {
      const int e0 = lane * 16 + q * 4;
      const float4 gt = *(const float4*)(mb + 2 * D + e0);
      const int o = q * 4;
      z[o] = ALPHA * x1[o] + gt.x * y[o]; z[o + 1] = ALPHA * x1[o + 1] + gt.y * y[o + 1];
      z[o + 2] = ALPHA * x1[o + 2] + gt.z * y[o + 2]; z[o + 3] = ALPHA * x1[o + 3] + gt.w * y[o + 3];
      s += z[o] + z[o + 1] + z[o + 2] + z[o + 3];
    }
    const float mu = wave_sum(s) * (1.0f / D);
    float qq = 0.f;
#pragma unroll
    for (int i = 0; i < 16; ++i) { z[i] -= mu; qq += z[i] * z[i]; }
    const float rstd = rsqrtf(wave_sum(qq) * (1.0f / D) + LN_EPS);
    const float* mbn = last ? nullptr : (p.mods() + ((size_t)((layer + 1) * 2 + 0) * 2 + b) * 3072);
#pragma unroll
    for (int q = 0; q < 4; ++q) {
      const int e0 = lane * 16 + q * 4;
      const float4 gg = *(const float4*)(g + e0);
      const float4 bb = *(const float4*)(be + e0);
      const int o = q * 4;
      float4 xo;
      xo.x = z[o] * rstd * gg.x + bb.x; xo.y = z[o + 1] * rstd * gg.y + bb.y;
      xo.z = z[o + 2] * rstd * gg.z + bb.z; xo.w = z[o + 3] * rstd * gg.w + bb.w;
      *(float4*)(dstx + (size_t)token * D + e0) = xo;
      if (!last) {
        const float4 sh = *(const float4*)(mbn + e0);
        const float4 scl = *(const float4*)(mbn + D + e0);
        *(uint2*)(p.hbuf() + (size_t)token * D + e0) =
            make_uint2(pack2(xo.x * (1.f + scl.x) + sh.x, xo.y * (1.f + scl.y) + sh.y), pack2(xo.z * (1.f + scl.z) + sh.z, xo.w * (1.f + scl.w) + sh.w));
      }
    }
    __syncthreads();
  }
}


#define XB_TMO      128
#define XB_XCNT(j)  (256  + 64 * (j))
#define XB_XSUB(j)  (1280 + 64 * (j))
#define XB_XGEN(j)  (2304 + 64 * (j))
#define XB_TOP      3328
#define XB_TOPGEN   3392
#define XCD_BAR_WORDS 3456
#define XB_SPIN_CAP (1u << 18)
#define LAS __attribute__((address_space(3)))
DI unsigned xb_ld(unsigned* p) { return __hip_atomic_load(p, __ATOMIC_RELAXED, __HIP_MEMORY_SCOPE_AGENT); }
DI unsigned xb_add(unsigned* p, unsigned v) { return __hip_atomic_fetch_add(p, v, __ATOMIC_RELAXED, __HIP_MEMORY_SCOPE_AGENT); }
DI unsigned xb_xcc_id() { return (unsigned)__builtin_amdgcn_s_getreg((3 << 11) | 20) & 0xFu; }
#define XB_SPIN(cond, bar) do { unsigned _sp = 0; while (cond) { __builtin_amdgcn_s_sleep(1); \
    if ((++_sp & 255u) == 0u) { if (xb_ld(&(bar)[XB_TMO])) break; if (_sp > XB_SPIN_CAP) { atomicAdd(&(bar)[XB_TMO], 1u); break; } } } } while (0)
struct XcdBarrier { unsigned* bar; unsigned x; volatile LAS unsigned* st; };
DI XcdBarrier xcd_barrier_post(unsigned* bar, volatile LAS unsigned* st, bool t0) {
  XcdBarrier b; b.bar = bar; b.x = xb_xcc_id(); b.st = st;
  if (t0) (void)xb_add(&bar[XB_XCNT(b.x)], 1u);
  return b;
}
DI void xcd_barrier_complete(unsigned* bar, unsigned x, unsigned& nloc, unsigned& nx) {
  const unsigned G = gridDim.x;
  unsigned sum, cnt, mine, sp = 0u;
  for (;;) {
    sum = 0u; cnt = 0u; mine = 0u;
#pragma unroll
    for (unsigned j = 0; j < 16; ++j) { const unsigned c = xb_ld(&bar[XB_XCNT(j)]); sum += c; cnt += (c > 0u) ? 1u : 0u; mine = (j == x) ? c : mine; }
    if (sum == G) break;
    __builtin_amdgcn_s_sleep(1);
    if ((++sp & 255u) == 0u) { if (xb_ld(&bar[XB_TMO])) break; if (sp > XB_SPIN_CAP) { atomicAdd(&bar[XB_TMO], 1u); break; } }
  }
  nloc = mine > 0u ? mine : 1u; nx = cnt > 0u ? cnt : 1u;
}
DI void xcd_barrier(const XcdBarrier& b, bool t0) {
  asm volatile("s_waitcnt vmcnt(0)" ::: "memory");
  __syncthreads();
  if (t0) {
    unsigned* bar = b.bar;
    __builtin_amdgcn_s_waitcnt(0);
    unsigned nloc = b.st[0], nx = b.st[1];
    if (nloc == 0u) { xcd_barrier_complete(bar, b.x, nloc, nx); b.st[0] = nloc; b.st[1] = nx; }
    const unsigned old = xb_add(&bar[XB_XSUB(b.x)], 1u);
    const unsigned gen = old / nloc;
    if (old + 1u == (gen + 1u) * nloc) {
      __builtin_amdgcn_fence(__ATOMIC_RELEASE, "agent");
      asm volatile("s_waitcnt vmcnt(0)" ::: "memory");
      const unsigned og = xb_add(&bar[XB_TOP], 1u);
      const unsigned tg = og / nx;
      if (og + 1u == (tg + 1u) * nx) xb_add(&bar[XB_TOPGEN], 1u);
      else XB_SPIN(xb_ld(&bar[XB_TOPGEN]) == tg, bar);
      __builtin_amdgcn_fence(__ATOMIC_ACQUIRE, "agent");
      xb_add(&bar[XB_XGEN(b.x)], 1u);
      asm volatile("s_waitcnt vmcnt(0)" ::: "memory");
    } else {
      XB_SPIN(xb_ld(&bar[XB_XGEN(b.x)]) == gen, bar);
      __builtin_amdgcn_fence(__ATOMIC_ACQUIRE, "agent");
      asm volatile("s_waitcnt vmcnt(0)" ::: "memory");
    }
  }
  __syncthreads();
}

typedef const __attribute__((address_space(4))) Params* KParamsPtr;
__global__ void __launch_bounds__(NTHR, 2) mega(Params p_arg) {
  extern __shared__ __attribute__((aligned(16))) char smem[];
  cg::grid_group grid = cg::this_grid();
  const int ph_lo = p_arg.ph_lo, ph_hi = p_arg.ph_hi;
  __shared__ uint4 xb_words;
  if (threadIdx.x == 0) xb_words = make_uint4(0u, 0u, 0u, 0u);
  __syncthreads();
  const XcdBarrier xb = xcd_barrier_post((unsigned*)(p_arg.ws + OFF_bar), (volatile LAS unsigned*)&xb_words, threadIdx.x == 0);
  const int wave_s = __builtin_amdgcn_readfirstlane(threadIdx.x >> 6);
  bool dup_done = false;
  for (int ph = ph_lo; ph < ph_hi; ++ph) {
#if FUSED_TOPK
    if (ph >= 2 && ((((ph - 2) & 7) == 6 && !TOPK_SEPARATE) || ((ph - 2) & 7) == 2)) continue;
#endif
    int ws_ = wave_s, zero_ = 0, bid_ = blockIdx.x;
    asm volatile("" : "+s"(ws_), "+s"(zero_), "+s"(bid_));
    const int tid_ = ws_ * 64 + (int)__builtin_amdgcn_mbcnt_hi(~0u, __builtin_amdgcn_mbcnt_lo(~0u, (unsigned)zero_));
#if defined(__HIP_DEVICE_COMPILE__)
    KParamsPtr kp = (KParamsPtr)__builtin_amdgcn_kernarg_segment_ptr();
    asm volatile("" : "+s"(kp));
    const Params p = *kp;
#else
    const Params p = p_arg;
#endif
    if (ph == 0) {
      phase_prep(p, smem, tid_, bid_);
    } else if (ph == 1) {
      phase_ln_mod(p, p.x, false, nullptr, nullptr, nullptr, p.mods(), p.hbuf(), tid_, bid_);
    } else {
      const int layer = (ph - 2) >> 3, sub = (ph - 2) & 7;
      const bool even = (layer & 1) == 0;
      const int li = layer >> 1;
      const float* xres = (layer == 0) ? p.x : p.x2buf();
      switch (sub) {
        case 0:
          if (even) phase_gemm<EPI_EVEN>(p, p.hbuf(), p.w_in_even_t() + (size_t)li * D * EVEN_IN, EVEN_IN, layer, nullptr, smem, tid_, bid_);
          else phase_gemm<EPI_ODD>(p, p.hbuf(), p.w_in_odd_t() + (size_t)li * D * ODD_IN, ODD_IN, layer, nullptr, smem, tid_, bid_);
          break;
        case 1:
#if NAIVE_ATTN
          if (even) phase_attn_even_naive(p, li, tid_, bid_);
          else phase_attn_odd_naive(p, li, tid_, bid_);
#else
          if (even) { phase_na_mfma(p, li, smem, tid_, bid_); phase_diff_mfma(p, li, smem, tid_, bid_); }
          else phase_swa_mfma(p, li, smem, tid_, bid_);
#endif
          break;
        case 2:
#if NAIVE_ATTN
          if (even) phase_diff_combine(p, li, tid_, bid_);
#endif
          break;
        case 3:
          phase_gemm<EPI_OUT>(p, p.obuf(), (even ? p.w_out_even_t() : p.w_out_odd_t()) + (size_t)li * D * D, D, layer, xres, smem, tid_, bid_);
          break;
        case 4:
          phase_ln_mod(p, p.zbuf(), true, p.ln_g + (size_t)(layer * 2) * D, p.ln_b + (size_t)(layer * 2) * D, nullptr  ,
                       p.mods() + (size_t)(layer * 2 + 1) * 2 * 3072, p.hbuf(), tid_, bid_);
          break;
        case 5:
          phase_gemm<EPI_Q>(p, p.hbuf(), p.wq_t() + (size_t)layer * D * 2048, 2048, layer, nullptr, smem, tid_, bid_);
          break;
        case 6:
#if !FUSED_TOPK
          phase_peer_topk(p, layer, smem, tid_, bid_);
#elif TOPK_SEPARATE
          phase_topk_mfma(p, layer, smem, tid_, bid_);
#endif
          break;
        case 7:
          phase_peer_final(p, layer, smem, tid_, bid_);
          break;
      }
    }
#if DUP_MASK
    if (ph >= 2 && ((DUP_MASK >> ((ph - 2) & 7)) & 1) && !dup_done) { dup_done = true; --ph; } else dup_done = false;
#endif
    if (ph + 1 < ph_hi) {
      asm volatile("s_waitcnt vmcnt(0)" ::: "memory");
      if (ph_hi > NPHASE) grid.sync();
      else xcd_barrier(xb, tid_ == 0);
    }
  }
}

extern "C" void kernel_launch(void* const* d_in, const int* in_sizes, int n_in, void* d_out, int out_size, void* d_ws, size_t ws_size,
                              hipStream_t stream) {
  static int grid_blocks = 0;
  if (!grid_blocks) {
    int dev = 0, cus = 0, per_cu = 0;
    hipGetDevice(&dev);
    hipDeviceGetAttribute(&cus, hipDeviceAttributeMultiprocessorCount, dev);
    hipOccupancyMaxActiveBlocksPerMultiprocessor(&per_cu, mega, NTHR, LDS_BYTES);
    if (per_cu < 1) per_cu = 1;
    if (per_cu > 2) per_cu = 2;
    grid_blocks = cus * per_cu;
    fprintf(stderr, "kernel_launch: cus %d per_cu %d grid %d ws %zu\n", cus, per_cu, grid_blocks, ws_size);
  }
  Params p{};
  const float** ins = (const float**)&p.x;
  for (int i = 0; i < 21; ++i) ins[i] = (const float*)d_in[i];
  p.out = (float*)d_out;
  p.ws = (char*)d_ws;
  const size_t off = WS_TOTAL;
  if (off > ws_size) { fprintf(stderr, "kernel_launch: workspace too small: need %zu have %zu\n", off, ws_size); return; }
#if ONE_LAUNCH
  (void)hipMemsetAsync((char*)d_ws + OFF_bar, 0, (size_t)XCD_BAR_WORDS_C * 4, stream);
  p.ph_lo = 0; p.ph_hi = NPHASE;
  void* args[] = {&p};
  hipError_t e = hipLaunchCooperativeKernel((void*)mega, dim3(grid_blocks), dim3(NTHR), args, LDS_BYTES, stream);
  if (e != hipSuccess) fprintf(stderr, "cooperative launch failed: %s (grid %d)\n", hipGetErrorString(e), grid_blocks);
#else
  for (int ph = 0; ph < NPHASE; ++ph) {
    if (((ph - 2) & 7) == 2 && ph >= 2 && (((ph - 2) >> 3) & 1)) continue;
    p.ph_lo = ph; p.ph_hi = ph + 1;
    hipLaunchKernelGGL(mega, dim3(grid_blocks), dim3(NTHR), LDS_BYTES, stream, p);
  }
#endif
}
```
